# Optimizing an MI355X kernel written in HIP

```python
import jax, jax.numpy as jnp
from jax import lax
import numpy as np

D_MODEL = 1024
BATCH = 16
SEQ = 2048
DEPTH = 1
DEC_BATCH = 128
DEC_SEQ = 8
PAST_LEN = 16384
PAGE_SIZE = 128

HEAD_DIM = 64
RWKV_WIDTH = D_MODEL // 2
RWKV_HEADS = RWKV_WIDTH // HEAD_DIM
ATTN_WIDTH = D_MODEL - RWKV_WIDTH
ATTN_Q_HEADS = ATTN_WIDTH // HEAD_DIM
ATTN_KV_HEADS = 2
ATTN_GROUP = ATTN_Q_HEADS // ATTN_KV_HEADS
KV_WIDTH = ATTN_KV_HEADS * HEAD_DIM
DECAY_LORA = 64
ICLR_LORA = 64
WINDOW = 128
BLOCK = WINDOW
ROPE_THETA = 500000.0
ROPE_DIM = HEAD_DIM // 4
PLE_DIM = 256
NORM_EPS = 1e-6
GN_EPS = 64e-5
NEG_INF = -1e30
SHIFT_DIM = 3 * RWKV_WIDTH + DECAY_LORA + ICLR_LORA
IN_DIM = SHIFT_DIM + RWKV_WIDTH + ATTN_WIDTH + 2 * KV_WIDTH + ATTN_WIDTH

kernel_name = 'hymba_rwkv7_swa_sink_step'


def rmsnorm(x, g):
    xf = x.astype(jnp.float32)
    y = xf * lax.rsqrt(jnp.mean(xf * xf, axis=-1, keepdims=True) + NORM_EPS)
    return (y * g.astype(jnp.float32)).astype(x.dtype)


def apply_rope(x, pos):
    half = ROPE_DIM // 2
    inv = ROPE_THETA ** (-jnp.arange(half, dtype=jnp.float32) / half)
    ang = pos.astype(jnp.float32)[:, None] * inv[None, :]
    cos = jnp.cos(ang)[:, None, :]
    sin = jnp.sin(ang)[:, None, :]
    xf = x[..., :ROPE_DIM].astype(jnp.float32)
    x1, x2 = xf[..., :half], xf[..., half:]
    rot = jnp.concatenate([x1 * cos - x2 * sin, x2 * cos + x1 * sin], axis=-1).astype(x.dtype)
    return jnp.concatenate([rot, x[..., ROPE_DIM:]], axis=-1)


def sink_softmax(s, mask, sink):
    s = jnp.where(mask, s, NEG_INF)
    sink = jnp.broadcast_to(sink.astype(jnp.float32), s.shape[:-1] + (1,))
    return jax.nn.softmax(jnp.concatenate([s, sink], axis=-1), axis=-1)[..., :-1]


def swa_prompt(q, k, v, sinks, pos):
    B, T = q.shape[:2]
    nb = T // BLOCK
    qb = q.reshape(B, nb, BLOCK, ATTN_KV_HEADS, ATTN_GROUP, HEAD_DIM)
    pad = ((0, 0), (BLOCK, 0), (0, 0), (0, 0))
    def band(t):
        tp = jnp.pad(t, pad)[:, :T].reshape(B, nb, BLOCK, ATTN_KV_HEADS, HEAD_DIM)
        return jnp.concatenate([tp, t.reshape(B, nb, BLOCK, ATTN_KV_HEADS, HEAD_DIM)], axis=2)
    kb, vb = band(k), band(v)
    qpos = pos.reshape(nb, BLOCK)
    kpos = jnp.concatenate([qpos - BLOCK, qpos], axis=1)
    diff = qpos[:, :, None] - kpos[:, None, :]
    mask = (diff >= 0) & (diff < WINDOW) & (kpos[:, None, :] >= 0)
    s = jnp.einsum('bnqhgd,bnkhd->bnhgqk', qb, kb).astype(jnp.float32) * (HEAD_DIM ** -0.5)
    p = sink_softmax(s, mask[None, :, None, None], sinks.reshape(ATTN_KV_HEADS, ATTN_GROUP)[:, :, None, None])
    o = jnp.einsum('bnhgqk,bnkhd->bnqhgd', p.astype(v.dtype), vb)
    return o.reshape(B, T, ATTN_WIDTH)


def swa_sample(q, k, v, kbuf, vbuf, sinks, pos):
    B, T = q.shape[:2]
    W = kbuf.shape[1]
    k_all = jnp.concatenate([kbuf.astype(k.dtype), k], axis=1)
    v_all = jnp.concatenate([vbuf.astype(v.dtype), v], axis=1)
    kpos = jnp.concatenate([PAST_LEN - W + jnp.arange(W), pos])
    diff = pos[:, None] - kpos[None, :]
    mask = (diff >= 0) & (diff < WINDOW)
    qg = q.reshape(B, T, ATTN_KV_HEADS, ATTN_GROUP, HEAD_DIM)
    s = jnp.einsum('bqhgd,bkhd->bhgqk', qg, k_all).astype(jnp.float32) * (HEAD_DIM ** -0.5)
    p = sink_softmax(s, mask, sinks.reshape(ATTN_KV_HEADS, ATTN_GROUP)[:, :, None, None])
    o = jnp.einsum('bhgqk,bkhd->bqhgd', p.astype(v.dtype), v_all).reshape(B, T, ATTN_WIDTH)
    return o, k_all[:, -W:], v_all[:, -W:]


def rwkv_time_mix(z_shift, shift0, S0, mu, w0, w2, a0, a2, k_k, k_a, r_k, ln_w, ln_b):
    B, T, _ = z_shift.shape
    H, D, R = RWKV_HEADS, HEAD_DIM, RWKV_WIDTH
    f32 = jnp.float32
    prev = jnp.concatenate([shift0[:, None].astype(z_shift.dtype), z_shift[:, :-1]], axis=1)
    zs = z_shift + mu * (prev - z_shift)
    r, kx, v = zs[..., :R], zs[..., R:2 * R], zs[..., 2 * R:3 * R]
    wd, ad = zs[..., 3 * R:3 * R + DECAY_LORA], zs[..., 3 * R + DECAY_LORA:]
    w_log = -jax.nn.softplus(-(w0 + jnp.tanh(wd) @ w2).astype(f32)) - 0.5
    decay = jnp.exp(-jnp.exp(w_log))
    a = jax.nn.sigmoid((a0 + ad @ a2).astype(f32))
    heads = lambda t: t.astype(f32).reshape(B, T, H, D)
    r, kx, v, decay, a = heads(r), heads(kx), heads(v), heads(decay), heads(a)
    kk = kx * k_k.astype(f32).reshape(H, D)
    kk = kk / jnp.maximum(jnp.linalg.norm(kk, axis=-1, keepdims=True), 1e-12)
    k = kx * (1.0 + (a - 1.0) * k_a.astype(f32).reshape(H, D))

    def step(S, inp):
        r_t, w_t, k_t, v_t, kk_t, a_t = inp
        sa = jnp.einsum('bhvk,bhk->bhv', S, kk_t)
        S = (S * w_t[:, :, None, :] - sa[..., None] * (kk_t * a_t)[:, :, None, :]
             + v_t[..., None] * k_t[:, :, None, :])
        return S, jnp.einsum('bhvk,bhk->bhv', S, r_t)

    xs = tuple(jnp.moveaxis(t, 1, 0) for t in (r, decay, k, v, kk, a))
    S_fin, y = lax.scan(step, S0.astype(f32), xs)
    y = jnp.moveaxis(y, 0, 1)
    mean = jnp.mean(y, axis=-1, keepdims=True)
    var = jnp.mean(jnp.square(y - mean), axis=-1, keepdims=True)
    yn = (y - mean) * lax.rsqrt(var + GN_EPS) * ln_w.astype(f32).reshape(H, D) + ln_b.astype(f32).reshape(H, D)
    bonus = jnp.sum(r * k * r_k.astype(f32).reshape(H, D), axis=-1, keepdims=True) * v
    out = (yn + bonus).reshape(B, T, R).astype(z_shift.dtype)
    return out, S_fin, z_shift[:, -1]


def mixer_layer(h, p, pos, S0, shift0, kbuf, vbuf, g_norm, w_in, mu, w0, w2, a0, a2,
                k_k, k_a, r_k, ln_w, ln_b, sinks, w_out, g_ple, w_pg, w_pp):
    B, T, _ = h.shape
    u = rmsnorm(h, g_norm)
    z = u @ w_in
    o1 = SHIFT_DIM
    o2 = o1 + RWKV_WIDTH
    o3 = o2 + ATTN_WIDTH
    o4 = o3 + KV_WIDTH
    o5 = o4 + KV_WIDTH
    z_shift, gate_r, q, k, v, gate_a = (z[..., :o1], z[..., o1:o2], z[..., o2:o3],
                                        z[..., o3:o4], z[..., o4:o5], z[..., o5:])
    o_r, S_new, shift_new = rwkv_time_mix(z_shift, shift0, S0, mu, w0, w2, a0, a2,
                                          k_k, k_a, r_k, ln_w, ln_b)
    q = apply_rope(q.reshape(B, T, ATTN_Q_HEADS, HEAD_DIM), pos)
    k = apply_rope(k.reshape(B, T, ATTN_KV_HEADS, HEAD_DIM), pos)
    v = v.reshape(B, T, ATTN_KV_HEADS, HEAD_DIM)
    if kbuf is None:
        o_a = swa_prompt(q, k, v, sinks, pos)
        n_keep = min(WINDOW, T)
        k_new, v_new = k[:, -n_keep:], v[:, -n_keep:]
    else:
        o_a, k_new, v_new = swa_sample(q, k, v, kbuf, vbuf, sinks, pos)
    mixed = jnp.concatenate([o_r * jax.nn.silu(gate_r), o_a * jax.nn.silu(gate_a)], axis=-1)
    h = h + mixed @ w_out
    gate = jax.nn.sigmoid(rmsnorm(h, g_ple) @ w_pg)
    h = h + gate * (p @ w_pp)
    return h, S_new.astype(h.dtype), shift_new, k_new, v_new


def setup_inputs(seed: int = 0) -> dict:
    key = jax.random.key(seed)
    ks = jax.random.split(key, 32)
    f32 = jnp.float32
    nrm = lambda k, shape, s: jax.random.normal(k, shape, f32) * s
    D, R = D_MODEL, RWKV_WIDTH
    WIN = min(WINDOW, PAST_LEN)
    return {
        'x_prompt': nrm(ks[0], (BATCH, SEQ, D), 1.0),
        'x_sample': nrm(ks[1], (DEC_BATCH, DEC_SEQ, D), 1.0),
        'state_rwkv_wkv': nrm(ks[2], (DEPTH, DEC_BATCH, RWKV_HEADS, HEAD_DIM, HEAD_DIM), 0.3),
        'state_rwkv_shift': nrm(ks[3], (DEPTH, DEC_BATCH, SHIFT_DIM), 1.0),
        'cache_swa_k': nrm(ks[4], (DEPTH, DEC_BATCH, WIN, ATTN_KV_HEADS, HEAD_DIM), 1.0),
        'cache_swa_v': nrm(ks[5], (DEPTH, DEC_BATCH, WIN, ATTN_KV_HEADS, HEAD_DIM), 1.0),
        'p_prompt': nrm(ks[6], (DEPTH, BATCH, SEQ, PLE_DIM), 1.0),
        'p_sample': nrm(ks[7], (DEPTH, DEC_BATCH, DEC_SEQ, PLE_DIM), 1.0),
        'g_norm': 1.0 + nrm(ks[8], (DEPTH, D), 0.05),
        'w_in': nrm(ks[9], (DEPTH, D, IN_DIM), D ** -0.5),
        'mu_shift': jax.random.uniform(ks[10], (DEPTH, SHIFT_DIM), f32, 0.1, 0.9),
        'w0': jax.random.uniform(ks[11], (DEPTH, R), f32, -4.0, 1.0),
        'w2': nrm(ks[12], (DEPTH, DECAY_LORA, R), 0.1),
        'a0': nrm(ks[13], (DEPTH, R), 0.1),
        'a2': nrm(ks[14], (DEPTH, ICLR_LORA, R), 0.1),
        'k_k': 0.85 + nrm(ks[15], (DEPTH, R), 0.05),
        'k_a': 1.0 + nrm(ks[16], (DEPTH, R), 0.05),
        'r_k': nrm(ks[17], (DEPTH, R), 0.1),
        'ln_w': 1.0 + nrm(ks[18], (DEPTH, R), 0.05),
        'ln_b': nrm(ks[19], (DEPTH, R), 0.02),
        'sinks': nrm(ks[20], (DEPTH, ATTN_Q_HEADS), 0.5),
        'w_out': nrm(ks[21], (DEPTH, D, D), D ** -0.5),
        'g_ple': 1.0 + nrm(ks[22], (DEPTH, D), 0.05),
        'w_ple_gate': nrm(ks[23], (DEPTH, D, D), D ** -0.5),
        'w_ple_proj': nrm(ks[24], (DEPTH, PLE_DIM, D), 0.5 * PLE_DIM ** -0.5),
        'g_final': 1.0 + nrm(ks[25], (D,), 0.05),
    }


def reference(x_prompt, x_sample, state_rwkv_wkv, state_rwkv_shift, cache_swa_k, cache_swa_v,
              p_prompt, p_sample, g_norm, w_in, mu_shift, w0, w2, a0, a2, k_k, k_a, r_k,
              ln_w, ln_b, sinks, w_out, g_ple, w_ple_gate, w_ple_proj, g_final):
    pos_p = jnp.arange(x_prompt.shape[1])
    pos_s = PAST_LEN + jnp.arange(x_sample.shape[1])
    hp, hs = x_prompt, x_sample
    Bp = x_prompt.shape[0]
    wkv_p, sh_p, k_p, v_p = [], [], [], []
    wkv_s, sh_s, k_s, v_s = [], [], [], []
    for l in range(DEPTH):
        wl = (g_norm[l], w_in[l], mu_shift[l], w0[l], w2[l], a0[l], a2[l], k_k[l], k_a[l], r_k[l],
              ln_w[l], ln_b[l], sinks[l], w_out[l], g_ple[l], w_ple_gate[l], w_ple_proj[l])
        S0p = jnp.zeros((Bp, RWKV_HEADS, HEAD_DIM, HEAD_DIM), jnp.float32)
        sh0p = jnp.zeros((Bp, SHIFT_DIM), hp.dtype)
        hp, S1, s1, k1, v1 = mixer_layer(hp, p_prompt[l], pos_p, S0p, sh0p, None, None, *wl)
        hs, S2, s2, k2, v2 = mixer_layer(hs, p_sample[l], pos_s, state_rwkv_wkv[l], state_rwkv_shift[l],
                                         cache_swa_k[l], cache_swa_v[l], *wl)
        wkv_p.append(S1); sh_p.append(s1); k_p.append(k1); v_p.append(v1)
        wkv_s.append(S2); sh_s.append(s2); k_s.append(k2); v_s.append(v2)
    y_prompt = rmsnorm(hp, g_final)
    y_sample = rmsnorm(hs, g_final)
    return (y_prompt, y_sample,
            jnp.stack(wkv_p), jnp.stack(sh_p), jnp.stack(k_p), jnp.stack(v_p),
            jnp.stack(wkv_s), jnp.stack(sh_s), jnp.stack(k_s), jnp.stack(v_s))
```

```cpp
#include <hip/hip_runtime.h>
#include <hip/hip_cooperative_groups.h>
#include <cstdio>
#include <cstdint>
namespace cg = cooperative_groups;

constexpr int DM = 1024, MP = 32768, MS = 1024, MTOT = MP + MS, SEQ = 2048, NB = 16, DB = 128, DSEQ = 8;
constexpr int NZ = 3584;
constexpr int IN_DIM = 3456, SHIFT = 1664, PLE = 256;
constexpr int O_GR = 1664, O_Q = 2176, O_K = 2688, O_V = 2816, O_GA = 2944;
constexpr float NORM_EPS = 1e-6f, GN_EPS = 64e-5f;
constexpr size_t OUT_Y = 0, OUT_WKVP = (size_t)MTOT * DM, OUT_SHP = OUT_WKVP + 16 * 8 * 4096, OUT_KP = OUT_SHP + 16 * SHIFT,
                 OUT_VP = OUT_KP + 16 * 128 * 128, OUT_WKVS = OUT_VP + 16 * 128 * 128, OUT_SHS = OUT_WKVS + (size_t)128 * 8 * 4096,
                 OUT_KS = OUT_SHS + 128 * SHIFT, OUT_VS = OUT_KS + (size_t)128 * 128 * 128;
constexpr size_t MiB = 1u << 20;
constexpr size_t WS_CTL = 0, CTL_BYTES = 1 * MiB;
constexpr size_t WS_WIN = 1 * MiB;
constexpr size_t WS_WOUT = 8 * MiB, WS_WPG = 10 * MiB, WS_WPP = 12 * MiB;
constexpr size_t WS_ROPE = 13 * MiB;
constexpr size_t WS_XN = 14 * MiB;
constexpr size_t WS_PB = 80 * MiB;
constexpr size_t WS_PP = 97 * MiB;
constexpr size_t WS_Z = 163 * MiB;
constexpr size_t CH_PQ = 0;
constexpr size_t CH_S = 96 * MiB;
constexpr size_t WS_RY = 395 * MiB;
constexpr size_t WS_BC = 459 * MiB;
constexpr size_t WS_W2T = 13 * MiB + 512 * 1024, WS_A2T = 13 * MiB + 640 * 1024;
constexpr size_t WS_END = 461 * MiB;
constexpr int CW_BAR = 512, CW_WORK = 0, CW_SS2 = 1024, CW_SS3 = CW_SS2 + MTOT;
constexpr int LDS_BYTES = 147456;

#define LAS __attribute__((address_space(3)))
typedef unsigned short bf16_t;
typedef short bf16x8 __attribute__((ext_vector_type(8)));
typedef float f32x4 __attribute__((ext_vector_type(4)));
typedef unsigned u32x4 __attribute__((ext_vector_type(4)));
typedef unsigned u32x2 __attribute__((ext_vector_type(2)));

typedef float f32x2_t __attribute__((ext_vector_type(2)));
typedef __bf16 bf16x2_t __attribute__((ext_vector_type(2)));
__device__ __forceinline__ unsigned pk2(float lo, float hi) { f32x2_t v = {lo, hi}; bf16x2_t b = __builtin_convertvector(v, bf16x2_t); return __builtin_bit_cast(unsigned, b); }
__device__ __forceinline__ unsigned f2bf(float f) { return pk2(f, 0.f) & 0xffffu; }
__device__ __forceinline__ float bf2f(unsigned h) { return __builtin_bit_cast(float, h << 16); }
__device__ __forceinline__ float bflo(unsigned u) { return __builtin_bit_cast(float, u << 16); }
__device__ __forceinline__ float bfhi(unsigned u) { return __builtin_bit_cast(float, u & 0xffff0000u); }
__device__ __forceinline__ void unpack8(u32x4 u, float* f) { f[0] = bflo(u.x); f[1] = bfhi(u.x); f[2] = bflo(u.y); f[3] = bfhi(u.y); f[4] = bflo(u.z); f[5] = bfhi(u.z); f[6] = bflo(u.w); f[7] = bfhi(u.w); }
__device__ __forceinline__ u32x4 pack8(const float* f) { u32x4 o; o.x = pk2(f[0], f[1]); o.y = pk2(f[2], f[3]); o.z = pk2(f[4], f[5]); o.w = pk2(f[6], f[7]); return o; }
__device__ __forceinline__ float wave_sum(float v) {
#pragma unroll
    for (int o = 1; o < 64; o <<= 1) v += __shfl_xor(v, o);
    return v;
}
template <int CTRL> __device__ __forceinline__ float dppf(float x) { return __builtin_bit_cast(float, __builtin_amdgcn_update_dpp(0, __builtin_bit_cast(int, x), CTRL, 0xf, 0xf, false)); }
__device__ __forceinline__ float red8_sum(float x) { x += dppf<0xB1>(x); x += dppf<0x4E>(x); x += dppf<0x141>(x); return x; }
__device__ __forceinline__ float red16_sum(float x) { x = red8_sum(x); x += dppf<0x140>(x); return x; }
__device__ __forceinline__ float red16_max(float x) { x = fmaxf(x, dppf<0xB1>(x)); x = fmaxf(x, dppf<0x4E>(x)); x = fmaxf(x, dppf<0x141>(x)); x = fmaxf(x, dppf<0x140>(x)); return x; }
__device__ __forceinline__ float sigmoidf_(float x) { return __builtin_amdgcn_rcpf(1.f + __expf(-x)); }
__device__ __forceinline__ float siluf_(float x) { return x * __builtin_amdgcn_rcpf(1.f + __expf(-x)); }
#define LDS_WAIT() asm volatile("s_waitcnt lgkmcnt(0)" ::: "memory")
#define LBAR() asm volatile("s_waitcnt lgkmcnt(0)\n\ts_barrier" ::: "memory")

namespace pg8 {
constexpr int BM = 256, BK = 64, HALF = 128, HTB = HALF * BK * 2  , STAGE_BYTES = 8 * HTB, NXCD = 8, WGM = 8;

__host__ __device__ __forceinline__ int lds_byte(int r, int c) { const int st = (r >> 4) * 2 + (c >> 5), rr = r & 15, cc = c & 31, ob = rr * 64 + cc * 2; return st * 1024 + (ob ^ (((ob >> 9) & 1) << 5)); }
__host__ __device__ __forceinline__ void stage_rc(int b, int& R, int& C) { const int st = b / 1024, sb = b % 1024, swz = sb ^ (((sb >> 9) & 1) << 5); R = (st >> 1) * 16 + swz / 64; C = (st & 1) * 32 + (swz % 64) / 2; }
__host__ __device__ __forceinline__ int perm32(int rho) { const int n = rho >> 4, i = rho & 15; return 8 * (i >> 2) + 4 * n + (i & 3); }

struct Unit { int pm, pn; };
struct Gemm { const bf16_t* A; const bf16_t* Bt; int M, N, K; };

struct StaticOrder {
    int nM, nN, nwg, G, c;
    __host__ __device__ void init(int M, int N, int G_, int c_) { nM = M / BM; nN = N / BM; nwg = nM * nN; G = G_; c = c_; }
    __host__ __device__ bool next(int i, Unit& u) const {
        const long L = (long)i * G + c; if (L >= nwg) return false;
        int wgid = (int)L; { const int q = nwg / NXCD, r = nwg % NXCD, xcd = wgid % NXCD, off = wgid / NXCD; wgid = (xcd < r ? xcd * (q + 1) : r * (q + 1) + (xcd - r) * q) + off; }
        const int nig = WGM * nN, gid = wgid / nig, fm = gid * WGM, gsz = (nM - fm) < WGM ? (nM - fm) : WGM;
        u.pm = fm + ((wgid % nig) % gsz); u.pn = (wgid % nig) / gsz; return true;
    }
    __device__ __forceinline__ void a_ready(const Unit&) const {}
    __device__ __forceinline__ void done(const Unit&) const {}
};

__device__ __forceinline__ unsigned cvt_pk_bf16(float lo, float hi) { unsigned r; asm volatile("v_cvt_pk_bf16_f32 %0, %1, %2" : "=v"(r) : "v"(lo), "v"(hi)); return r; }

struct EpiBf16 {
    static constexpr bool PERM = true, AFTER_DRAIN = false;
    bf16_t* O; int ldc;
    __device__ __forceinline__ void operator()(const f32x4 (&acc)[2][2][4][2], const Unit& u, int wr, int wc, int fr, int fq) const {
        const int row0 = u.pm * BM + wr * 64 + fr; const int col0 = u.pn * BM + wc * 32 + 8 * fq;
#pragma unroll
        for (int ai = 0; ai < 2; ++ai)
#pragma unroll
            for (int m = 0; m < 4; ++m) { bf16_t* rowp = O + (size_t)(row0 + ai * HALF + m * 16) * ldc + col0;
#pragma unroll
                for (int bj = 0; bj < 2; ++bj) { const f32x4 v0 = acc[ai][bj][m][0], v1 = acc[ai][bj][m][1];
                    u32x4 w; w.x = cvt_pk_bf16(v0[0], v0[1]); w.y = cvt_pk_bf16(v0[2], v0[3]); w.z = cvt_pk_bf16(v1[0], v1[1]); w.w = cvt_pk_bf16(v1[2], v1[3]);
                    *(u32x4*)(rowp + bj * HALF) = w; } }
    }
};

struct EpiRes {
    static constexpr bool PERM = true, AFTER_DRAIN = false;
    const float* xp; const float* xs; float* out; bf16_t* h2b; float* rowss;
    __device__ __forceinline__ void operator()(const f32x4 (&acc)[2][2][4][2], const Unit& u, int wr, int wc, int fr, int fq) const {
        const int row0 = u.pm * BM + wr * 64 + fr; const int col0 = u.pn * BM + wc * 32 + 8 * fq;
#pragma unroll
        for (int ai = 0; ai < 2; ++ai)
#pragma unroll
            for (int m = 0; m < 4; ++m) { const int row = row0 + ai * HALF + m * 16;
                const float* xr = (row < MP ? xp + (size_t)row * DM : xs + (size_t)(row - MP) * DM) + col0;
                bf16_t* brow = h2b + (size_t)row * DM + col0; float ss = 0.f;
#pragma unroll
                for (int bj = 0; bj < 2; ++bj) { const f32x4 x0 = *(const f32x4*)(xr + bj * HALF), x1 = *(const f32x4*)(xr + bj * HALF + 4);
                    const f32x4 v0 = acc[ai][bj][m][0] + x0, v1 = acc[ai][bj][m][1] + x1;
                    u32x4 w; w.x = cvt_pk_bf16(v0[0], v0[1]); w.y = cvt_pk_bf16(v0[2], v0[3]); w.z = cvt_pk_bf16(v1[0], v1[1]); w.w = cvt_pk_bf16(v1[2], v1[3]);
                    *(u32x4*)(brow + bj * HALF) = w;
                    ss += v0[0] * v0[0] + v0[1] * v0[1] + v0[2] * v0[2] + v0[3] * v0[3] + v1[0] * v1[0] + v1[1] * v1[1] + v1[2] * v1[2] + v1[3] * v1[3]; }
                ss += __shfl_xor(ss, 16); ss += __shfl_xor(ss, 32);
                if (fq == 0) atomicAdd(rowss + row, ss); }
    }
};

struct EpiGate {
    static constexpr bool PERM = true, AFTER_DRAIN = false;
    const bf16_t* h2b; bf16_t* h3b; const bf16_t* pp; const float* rowss2; float* rowss3;
    __device__ __forceinline__ void operator()(const f32x4 (&acc)[2][2][4][2], const Unit& u, int wr, int wc, int fr, int fq) const {
        const int row0 = u.pm * BM + wr * 64 + fr; const int col0 = u.pn * BM + wc * 32 + 8 * fq;
#pragma unroll
        for (int ai = 0; ai < 2; ++ai)
#pragma unroll
            for (int m = 0; m < 4; ++m) { const int row = row0 + ai * HALF + m * 16;
                const float rstd = __builtin_amdgcn_rsqf(rowss2[row] * (1.f / DM) + NORM_EPS);
                const bf16_t* hrow = h2b + (size_t)row * DM + col0; bf16_t* orow = h3b + (size_t)row * DM + col0; const bf16_t* prow = pp + (size_t)row * DM + col0; float ss = 0.f;
#pragma unroll
                for (int bj = 0; bj < 2; ++bj) { const u32x4 hw = *(const u32x4*)(hrow + bj * HALF); float hf[8]; unpack8(hw, hf);
                    const u32x4 pw = *(const u32x4*)(prow + bj * HALF); float pf[8]; unpack8(pw, pf);
                    const f32x4 a0 = acc[ai][bj][m][0], a1 = acc[ai][bj][m][1]; f32x4 v0, v1;
#pragma unroll
                    for (int e = 0; e < 4; ++e) { v0[e] = hf[e] + sigmoidf_(a0[e] * rstd) * pf[e]; v1[e] = hf[4 + e] + sigmoidf_(a1[e] * rstd) * pf[4 + e]; }
                    u32x4 w; w.x = cvt_pk_bf16(v0[0], v0[1]); w.y = cvt_pk_bf16(v0[2], v0[3]); w.z = cvt_pk_bf16(v1[0], v1[1]); w.w = cvt_pk_bf16(v1[2], v1[3]);
                    *(u32x4*)(orow + bj * HALF) = w;
                    ss += v0[0] * v0[0] + v0[1] * v0[1] + v0[2] * v0[2] + v0[3] * v0[3] + v1[0] * v1[0] + v1[1] * v1[1] + v1[2] * v1[2] + v1[3] * v1[3]; }
                ss += __shfl_xor(ss, 16); ss += __shfl_xor(ss, 32);
                if (fq == 0) atomicAdd(rowss3 + row, ss); }
    }
};

template <class Epi, class Sched, bool ALIGN_EPI = false, bool SP2 = false>
__device__ __forceinline__ void gemm_phase(LAS unsigned char* lds, const Gemm g, const Sched& S, const Epi& E) {
    const int tid = threadIdx.x, wid = __builtin_amdgcn_readfirstlane(tid >> 6), lane = tid & 63, wr = wid >> 2, wc = wid & 3, fr = lane & 15, fq = lane >> 4;
    const int K = g.K, nt = K / BK;
    unsigned voffA[2], voffB[2];
#pragma unroll
    for (int i = 0; i < 2; ++i) { int R, C; stage_rc(tid * 16 + i * 8192, R, C); const int Rb = Epi::PERM ? ((R & ~31) + perm32(R & 31)) : R;
        voffA[i] = (unsigned)(R * K + C) * 2u; voffB[i] = (unsigned)(Rb * K + C) * 2u; }
    const size_t kstep = (size_t)(BK * 2);
    const size_t hstep = (size_t)HALF * K * 2;
    const size_t tstep = 2 * hstep;
    const unsigned ldsw = (unsigned)wid * 1024u;
    const int aoff = lds_byte(wr * 64 + fr, fq * 8), boff = lds_byte(wc * 32 + fr, fq * 8);
#define PG8_SA(b, h) (((b) * 2 + (h)) * HTB)
#define PG8_SB(b, h) ((4 + (b) * 2 + (h)) * HTB)
#define PG8_STAGE(bufoff, gbase, voff) do { _Pragma("unroll") for (int _i = 0; _i < 2; ++_i) \
        __builtin_amdgcn_global_load_lds((const unsigned*)((const char*)(gbase) + (voff)[_i]), (LAS unsigned*)(lds + (bufoff) + ldsw + _i * 8192), 16, 0, 0); } while (0)
#define PG8_LDA(dst, b, h) do { _Pragma("unroll") for (int m = 0; m < 4; ++m) _Pragma("unroll") for (int k = 0; k < 2; ++k) dst[m][k] = *(const LAS bf16x8*)(lds + PG8_SA(b, h) + aoff + m * 2048 + k * 1024); } while (0)
#define PG8_LDB(dst, b, h) do { _Pragma("unroll") for (int n = 0; n < 2; ++n) _Pragma("unroll") for (int k = 0; k < 2; ++k) dst[n][k] = *(const LAS bf16x8*)(lds + PG8_SB(b, h) + boff + n * 2048 + k * 1024); } while (0)
#define PG8_MMA(ai, bj, At, Bt) do { __builtin_amdgcn_s_setprio(1); _Pragma("unroll") for (int m = 0; m < 4; ++m) _Pragma("unroll") for (int n = 0; n < 2; ++n) _Pragma("unroll") for (int k = 0; k < 2; ++k) \
        acc[ai][bj][m][n] = __builtin_amdgcn_mfma_f32_16x16x32_bf16(Bt[n][k], At[m][k], acc[ai][bj][m][n], 0, 0, 0); __builtin_amdgcn_s_setprio(0); } while (0)
#define PG8_WAIT_V(n) asm volatile("s_waitcnt vmcnt(" #n ")" ::: "memory")
#define PG8_WAIT_L(n) asm volatile("s_waitcnt lgkmcnt(" #n ")" ::: "memory")
#define PG8_BAR __builtin_amdgcn_s_barrier()
#define PG8_SCHED __builtin_amdgcn_sched_barrier(0)
    Unit cur, nxt; int ui = 0;
    if (!S.next(0, cur)) return;
    f32x4 acc[2][2][4][2];
#pragma unroll
    for (int a = 0; a < 2; ++a)
#pragma unroll
        for (int b = 0; b < 2; ++b)
#pragma unroll
            for (int m = 0; m < 4; ++m)
#pragma unroll
                for (int n = 0; n < 2; ++n) acc[a][b][m][n] = (f32x4){0.f, 0.f, 0.f, 0.f};
    bf16x8 At[4][2], B0[2][2], B1[2][2];
    const char* cA = (const char*)g.A + (size_t)cur.pm * tstep; const char* cB = (const char*)g.Bt + (size_t)cur.pn * tstep;
    S.a_ready(cur);
    if constexpr (SP2) {
        PG8_STAGE(PG8_SB(0, 0), cB, voffB); PG8_STAGE(PG8_SB(0, 1), cB + hstep, voffB); PG8_STAGE(PG8_SA(0, 0), cA, voffA); PG8_STAGE(PG8_SA(0, 1), cA + hstep, voffA);
        if (wr == 1) PG8_BAR;
        PG8_WAIT_V(2); PG8_BAR;
        PG8_STAGE(PG8_SB(1, 0), cB + kstep, voffB); PG8_STAGE(PG8_SA(1, 0), cA + kstep, voffA); PG8_STAGE(PG8_SB(1, 1), cB + hstep + kstep, voffB);
        PG8_WAIT_V(6); PG8_BAR;
    } else {
        PG8_STAGE(PG8_SB(0, 0), cB, voffB); PG8_STAGE(PG8_SA(0, 0), cA, voffA); PG8_STAGE(PG8_SB(0, 1), cB + hstep, voffB); PG8_STAGE(PG8_SA(0, 1), cA + hstep, voffA);
        if (wr == 1) PG8_BAR;
        PG8_WAIT_V(4); PG8_BAR;
        PG8_STAGE(PG8_SB(1, 0), cB + kstep, voffB); PG8_STAGE(PG8_SA(1, 0), cA + kstep, voffA); PG8_STAGE(PG8_SB(1, 1), cB + hstep + kstep, voffB);
        PG8_WAIT_V(6); PG8_BAR;
    }
    for (;;) {
        const bool has_next = S.next(ui + 1, nxt);
        const char* nA = has_next ? (const char*)g.A + (size_t)nxt.pm * tstep : cA; const char* nB = has_next ? (const char*)g.Bt + (size_t)nxt.pn * tstep : cB;
        for (int t = 0; t < nt; t += 2) {
            const bool last = (t == nt - 2);
            const char* a1 = cA + (size_t)(t + 1) * kstep;
            const char* a2 = last ? nA : cA + (size_t)(t + 2) * kstep; const char* b2 = last ? nB : cB + (size_t)(t + 2) * kstep;
            const char* a3 = a2 + kstep; const char* b3 = b2 + kstep;
            if (last && has_next) S.a_ready(nxt);
            if constexpr (SP2) {
            PG8_LDB(B0, 0, 0); PG8_LDB(B1, 0, 1); PG8_SCHED; PG8_LDA(At, 0, 0); PG8_STAGE(PG8_SA(1, 1), a1 + hstep, voffA);
            PG8_WAIT_V(8); PG8_WAIT_L(0); PG8_BAR; PG8_MMA(0, 0, At, B0); PG8_MMA(0, 1, At, B1); PG8_BAR; PG8_SCHED;
            PG8_LDA(At, 0, 1); PG8_STAGE(PG8_SB(0, 0), b2, voffB); PG8_STAGE(PG8_SB(0, 1), b2 + hstep, voffB); PG8_STAGE(PG8_SA(0, 0), a2, voffA);
            PG8_WAIT_V(8); PG8_WAIT_L(0); PG8_BAR; PG8_MMA(1, 0, At, B0); PG8_MMA(1, 1, At, B1); PG8_BAR; PG8_SCHED;
            PG8_LDB(B0, 1, 0); PG8_LDB(B1, 1, 1); PG8_SCHED; PG8_LDA(At, 1, 0); PG8_STAGE(PG8_SA(0, 1), a2 + hstep, voffA);
            PG8_WAIT_V(8); PG8_WAIT_L(0); PG8_BAR; PG8_MMA(0, 0, At, B0); PG8_MMA(0, 1, At, B1); PG8_BAR; PG8_SCHED;
            PG8_LDA(At, 1, 1); PG8_STAGE(PG8_SB(1, 0), b3, voffB); PG8_STAGE(PG8_SB(1, 1), b3 + hstep, voffB); PG8_STAGE(PG8_SA(1, 0), a3, voffA);
            PG8_WAIT_V(8); PG8_WAIT_L(0); PG8_BAR; PG8_MMA(1, 0, At, B0); PG8_MMA(1, 1, At, B1); PG8_BAR; PG8_SCHED;
            } else {
            PG8_LDB(B0, 0, 0); PG8_SCHED; PG8_LDA(At, 0, 0); PG8_STAGE(PG8_SA(1, 1), a1 + hstep, voffA);
            PG8_WAIT_L(8); PG8_BAR; PG8_WAIT_L(0); PG8_MMA(0, 0, At, B0); PG8_BAR; PG8_SCHED;
            PG8_LDB(B1, 0, 1); PG8_STAGE(PG8_SB(0, 0), b2, voffB);
            PG8_BAR; PG8_WAIT_L(0); PG8_MMA(0, 1, At, B1); PG8_BAR;
            PG8_LDA(At, 0, 1); PG8_STAGE(PG8_SA(0, 0), a2, voffA);
            PG8_BAR; PG8_WAIT_L(0); PG8_MMA(1, 0, At, B0); PG8_BAR; PG8_SCHED;
            PG8_STAGE(PG8_SB(0, 1), b2 + hstep, voffB);
            PG8_WAIT_V(6); PG8_BAR; PG8_MMA(1, 1, At, B1); PG8_BAR;
            PG8_LDB(B0, 1, 0); PG8_SCHED; PG8_LDA(At, 1, 0); PG8_STAGE(PG8_SA(0, 1), a2 + hstep, voffA);
            PG8_WAIT_L(8); PG8_BAR; PG8_WAIT_L(0); PG8_MMA(0, 0, At, B0); PG8_BAR; PG8_SCHED;
            PG8_LDB(B1, 1, 1); PG8_STAGE(PG8_SB(1, 0), b3, voffB);
            PG8_BAR; PG8_WAIT_L(0); PG8_MMA(0, 1, At, B1); PG8_BAR;
            PG8_LDA(At, 1, 1); PG8_STAGE(PG8_SA(1, 0), a3, voffA);
            PG8_BAR; PG8_WAIT_L(0); PG8_MMA(1, 0, At, B0); PG8_BAR; PG8_SCHED;
            PG8_STAGE(PG8_SB(1, 1), b3 + hstep, voffB);
            PG8_WAIT_V(6); PG8_BAR; PG8_MMA(1, 1, At, B1); PG8_BAR;
            }
        }
        if constexpr (ALIGN_EPI) { if (wr == 0) PG8_BAR; }
        if constexpr (!Epi::AFTER_DRAIN) { E(acc, cur, wr, wc, fr, fq); S.done(cur); }
        if (!has_next) break;
#pragma unroll
        for (int a = 0; a < 2; ++a)
#pragma unroll
            for (int b = 0; b < 2; ++b)
#pragma unroll
                for (int m = 0; m < 4; ++m)
#pragma unroll
                    for (int n = 0; n < 2; ++n) acc[a][b][m][n] = (f32x4){0.f, 0.f, 0.f, 0.f};
        cur = nxt; cA = nA; cB = nB; ++ui;
        if constexpr (ALIGN_EPI) { if (wr == 1) PG8_BAR; }
    }
    PG8_WAIT_V(0);
    if constexpr (!ALIGN_EPI) { if (wr == 0) PG8_BAR; }
    PG8_BAR;
    if constexpr (Epi::AFTER_DRAIN) { E.fused(acc, cur, wr, wc, fr, fq, lds, wid, lane); S.done(cur); }
#undef PG8_SA
#undef PG8_SB
#undef PG8_STAGE
#undef PG8_LDA
#undef PG8_LDB
#undef PG8_MMA
#undef PG8_WAIT_V
#undef PG8_WAIT_L
#undef PG8_BAR
#undef PG8_SCHED
}
}

struct Args {
    const float *x_prompt, *x_sample, *st_wkv, *st_shift, *cache_k, *cache_v, *p_prompt, *p_sample, *g_norm, *w_in, *mu, *w0, *w2, *a0, *a2,
                *k_k, *k_a, *r_k, *ln_w, *ln_b, *sinks, *w_out, *g_ple, *w_pg, *w_pp, *g_final;
    float* out; unsigned char* ws;
};

__device__ __forceinline__ void p0_transpose_item(const float* W, int K, int N, bf16_t* WT, const float* kscale, LAS float* scr, int item, int lane) {
    const int nblk = N / 32, kb = item / nblk, nb = item % nblk, k0 = 64 * kb, n0 = 32 * nb;
    float wv[32];
#pragma unroll
    for (int i = 0; i < 32; ++i) { const int kk = 2 * i + (lane >> 5); wv[i] = W[(size_t)(k0 + kk) * N + n0 + (lane & 31)]; }
#pragma unroll
    for (int i = 0; i < 32; ++i) { const int kk = 2 * i + (lane >> 5); float v = wv[i]; if (kscale) v *= kscale[k0 + kk]; scr[kk * 33 + (lane & 31)] = v; }
    LDS_WAIT();
    const int c = lane & 7;
#pragma unroll
    for (int j = 0; j < 4; ++j) { const int n = (lane >> 3) + 8 * j; const LAS float* s = scr + (8 * c) * 33 + n;
        u32x4 o; o.x = pk2(s[0 * 33], s[1 * 33]); o.y = pk2(s[2 * 33], s[3 * 33]); o.z = pk2(s[4 * 33], s[5 * 33]); o.w = pk2(s[6 * 33], s[7 * 33]);
        *(u32x4*)(WT + (size_t)(n0 + n) * K + k0 + 8 * c) = o; }
    LDS_WAIT();
}

__device__ __forceinline__ void p0_prologue(const Args& A, LAS unsigned char* lds, int tid, int lane, int wave) {
    unsigned char* ws = A.ws;
    LAS float* scr = (LAS float*)(lds + wave * 16384);
    const int gw = blockIdx.x * 8 + wave, NGW = gridDim.x * 8;
    bf16_t* Win_t = (bf16_t*)(ws + WS_WIN); bf16_t* Wout_t = (bf16_t*)(ws + WS_WOUT); bf16_t* Wpg_t = (bf16_t*)(ws + WS_WPG); bf16_t* Wpp_t = (bf16_t*)(ws + WS_WPP);
    constexpr int I_IN = 16 * (IN_DIM / 32), I_O = 16 * 32, I_PG = 16 * 32, I_PP = 4 * 32, NITEMS = I_IN + I_O + I_PG + I_PP;
    for (int it = gw; it < NITEMS; it += NGW) {
        int r = it;
        if (r < I_IN) { p0_transpose_item(A.w_in, DM, IN_DIM, Win_t, nullptr, scr, r, lane); continue; } r -= I_IN;
        if (r < I_O) { p0_transpose_item(A.w_out, DM, DM, Wout_t, nullptr, scr, r, lane); continue; } r -= I_O;
        if (r < I_PG) { p0_transpose_item(A.w_pg, DM, DM, Wpg_t, A.g_ple, scr, r, lane); continue; } r -= I_PG;
        p0_transpose_item(A.w_pp, PLE, DM, Wpp_t, nullptr, scr, r, lane);
    }
    { unsigned* ctl = (unsigned*)(ws + WS_CTL); const int gt = blockIdx.x * 512 + tid, NT = gridDim.x * 512;
      for (int i = gt; i < CW_SS3 + MTOT; i += NT) ctl[i] = 0u; }
    { const int gt = blockIdx.x * 512 + tid, NT = gridDim.x * 512; u32x4* zp = (u32x4*)(Win_t + (size_t)IN_DIM * DM);
      for (int i = gt; i < (NZ - IN_DIM) * DM / 8; i += NT) zp[i] = (u32x4){0u, 0u, 0u, 0u}; }
    { const int gt = blockIdx.x * 512 + tid, NT = gridDim.x * 512; float* ct = (float*)(ws + WS_ROPE); float* st = ct + 2056 * 8;
      for (int i = gt; i < 2056 * 8; i += NT) { const int pi = i >> 3, fi = i & 7; const int pos = pi < 2048 ? pi : 16384 + pi - 2048;
          const float inv = fi == 0 ? 1.0f : fi == 1 ? 0.19392274f : fi == 2 ? 0.03760603f : fi == 3 ? 0.0072926646f : fi == 4 ? 0.0014142136f : fi == 5 ? 0.0002742482f : fi == 6 ? 5.3182957e-05f : 1.0313385e-05f;
          const float angf = (float)pos * inv; const double ang = (double)angf; const double n = __builtin_rint(ang * 0.15915494309189535); const double r = __builtin_fma(-n, 6.283185307179586, ang);
          const float rf = (float)r; ct[i] = cosf(rf); st[i] = sinf(rf); } }
    { const int gt = blockIdx.x * 512 + tid, NT = gridDim.x * 512; bf16_t* W2T = (bf16_t*)(ws + WS_W2T); bf16_t* A2T = (bf16_t*)(ws + WS_A2T);
      for (int i = gt; i < 512 * 64; i += NT) { const int cc = i >> 6, j = i & 63; W2T[i] = (bf16_t)f2bf(A.w2[j * 512 + cc]); A2T[i] = (bf16_t)f2bf(A.a2[j * 512 + cc]); } }
    bf16_t* XN = (bf16_t*)(ws + WS_XN); bf16_t* PB = (bf16_t*)(ws + WS_PB);
    f32x4 gv[4];
#pragma unroll
    for (int j = 0; j < 4; ++j) gv[j] = *((const f32x4*)A.g_norm + lane + 64 * j);
    {
        f32x4 v[4], nv[4]; f32x4 pv, npv;
        int m = gw;
        if (m < MTOT) { const float* xrow = m < MP ? A.x_prompt + (size_t)m * DM : A.x_sample + (size_t)(m - MP) * DM; const float* prow = m < MP ? A.p_prompt + (size_t)m * PLE : A.p_sample + (size_t)(m - MP) * PLE;
#pragma unroll
            for (int j = 0; j < 4; ++j) v[j] = *((const f32x4*)xrow + lane + 64 * j);
            pv = *((const f32x4*)prow + lane); }
        for (; m < MTOT; m += NGW) {
            const int mn = m + NGW;
            if (mn < MTOT) { const float* xrow = mn < MP ? A.x_prompt + (size_t)mn * DM : A.x_sample + (size_t)(mn - MP) * DM; const float* prow = mn < MP ? A.p_prompt + (size_t)mn * PLE : A.p_sample + (size_t)(mn - MP) * PLE;
#pragma unroll
                for (int j = 0; j < 4; ++j) nv[j] = *((const f32x4*)xrow + lane + 64 * j);
                npv = *((const f32x4*)prow + lane); }
            float s = 0.f;
#pragma unroll
            for (int j = 0; j < 4; ++j) s += (v[j].x * v[j].x + v[j].y * v[j].y) + (v[j].z * v[j].z + v[j].w * v[j].w);
            const float rstd = __builtin_amdgcn_rsqf(wave_sum(s) * (1.f / DM) + NORM_EPS);
            u32x2* o8 = (u32x2*)(XN + (size_t)m * DM) + lane;
#pragma unroll
            for (int j = 0; j < 4; ++j) { u32x2 o; o.x = pk2(v[j].x * rstd * gv[j].x, v[j].y * rstd * gv[j].y); o.y = pk2(v[j].z * rstd * gv[j].z, v[j].w * rstd * gv[j].w); o8[64 * j] = o; }
            u32x2 po; po.x = pk2(pv.x, pv.y); po.y = pk2(pv.z, pv.w);
            *((u32x2*)(PB + (size_t)m * PLE) + lane) = po;
#pragma unroll
            for (int j = 0; j < 4; ++j) v[j] = nv[j];
            pv = npv;
        }
    }
}

constexpr int SC_ZS = 0, SC_OP = 40960, SC_Y = 81920, SC_C = 90112;
__device__ __forceinline__ void sscan_item(const Args& A, LAS unsigned char* lds, int tid, int lane, int wave, int bg, int h) {
    const bf16_t* Z = (const bf16_t*)(A.ws + WS_Z); bf16_t* MIX = (bf16_t*)(A.ws + WS_XN);
    LAS float* ZS = (LAS float*)(lds + SC_ZS); LAS float* OP = (LAS float*)(lds + SC_OP); LAS float* YB = (LAS float*)(lds + SC_Y); LAS float* CB = (LAS float*)(lds + SC_C);
    const int fr = lane & 15, q4 = lane >> 4;
    const int mt = wave & 1, nt = wave >> 1, cl = nt * 16 + fr, cg_ = h * 64 + cl;
    bf16x8 bw[2], ba[2];
#pragma unroll
    for (int ks = 0; ks < 2; ++ks) { bw[ks] = *(const bf16x8*)((const bf16_t*)(A.ws + WS_W2T) + cg_ * 64 + ks * 32 + q4 * 8); ba[ks] = *(const bf16x8*)((const bf16_t*)(A.ws + WS_A2T) + cg_ * 64 + ks * 32 + q4 * 8); }
    const float w0c = A.w0[cg_], a0c = A.a0[cg_], kkc = A.k_k[cg_], kac = A.k_a[cg_];
    const float rkl = A.r_k[h * 64 + lane], lnw = A.ln_w[h * 64 + lane], lnb = A.ln_b[h * 64 + lane];
    const int vr = (tid >> 3) & 31, kq = tid & 7;
    f32x4 s0pre[2][4];
#pragma unroll
    for (int rep = 0; rep < 2; ++rep) { const int b_ = bg * 4 + (tid >> 8) + 2 * rep; const float* S0_ = A.st_wkv + ((size_t)b_ * 8 + h) * 4096;
        s0pre[rep][0] = *(const f32x4*)(S0_ + vr * 64 + kq * 8); s0pre[rep][1] = *(const f32x4*)(S0_ + vr * 64 + kq * 8 + 4);
        s0pre[rep][2] = *(const f32x4*)(S0_ + (vr + 32) * 64 + kq * 8); s0pre[rep][3] = *(const f32x4*)(S0_ + (vr + 32) * 64 + kq * 8 + 4); }
    {
        for (int idx = tid; idx < 32 * 40; idx += 512) {
            const int t = idx / 40, cc = idx % 40, s = cc >> 3, within = (cc & 7) * 8;
            float o[8];
            {
                const int bi = t >> 3, tt = t & 7, b = bg * 4 + bi; const float* shift0 = A.st_shift + (size_t)b * SHIFT;
                const int zcol = (s == 0 ? h * 64 : s == 1 ? 512 + h * 64 : s == 2 ? 1024 + h * 64 : s == 3 ? 1536 : 1600) + within;
                const size_t row = (size_t)MP + (size_t)b * 8 + tt;
                float cur[8], prv[8]; unpack8(*(const u32x4*)(Z + row * NZ + zcol), cur);
                if (tt == 0) {
                    { const f32x4 p0 = *(const f32x4*)(shift0 + zcol), p1 = *(const f32x4*)(shift0 + zcol + 4);
                        prv[0] = p0.x; prv[1] = p0.y; prv[2] = p0.z; prv[3] = p0.w; prv[4] = p1.x; prv[5] = p1.y; prv[6] = p1.z; prv[7] = p1.w; }
                } else unpack8(*(const u32x4*)(Z + (row - 1) * NZ + zcol), prv);
                const f32x4 m0 = *(const f32x4*)(A.mu + zcol), m1 = *(const f32x4*)(A.mu + zcol + 4);
                const float mu[8] = {m0.x, m0.y, m0.z, m0.w, m1.x, m1.y, m1.z, m1.w};
#pragma unroll
                for (int i = 0; i < 8; ++i) { float v = cur[i] + mu[i] * (prv[i] - cur[i]); if (s == 3) v = tanhf(v); o[i] = v; }
            }
            LAS f32x4* dst = (LAS f32x4*)(ZS + t * 320 + s * 64 + within);
            dst[0] = (f32x4){o[0], o[1], o[2], o[3]}; dst[1] = (f32x4){o[4], o[5], o[6], o[7]};
        }
        __syncthreads();
        {
            f32x4 accw = {0.f, 0.f, 0.f, 0.f}, acca = {0.f, 0.f, 0.f, 0.f};
#pragma unroll
            for (int ks = 0; ks < 2; ++ks) {
                const LAS f32x4* pt = (const LAS f32x4*)(ZS + (mt * 16 + fr) * 320 + 192 + ks * 32 + q4 * 8);
                const LAS f32x4* pa = (const LAS f32x4*)(ZS + (mt * 16 + fr) * 320 + 256 + ks * 32 + q4 * 8);
                const f32x4 t0v = pt[0], t1v = pt[1], a0v = pa[0], a1v = pa[1];
                u32x4 tw; tw.x = pk2(t0v.x, t0v.y); tw.y = pk2(t0v.z, t0v.w); tw.z = pk2(t1v.x, t1v.y); tw.w = pk2(t1v.z, t1v.w);
                u32x4 aw; aw.x = pk2(a0v.x, a0v.y); aw.y = pk2(a0v.z, a0v.w); aw.z = pk2(a1v.x, a1v.y); aw.w = pk2(a1v.z, a1v.w);
                accw = __builtin_amdgcn_mfma_f32_16x16x32_bf16(__builtin_bit_cast(bf16x8, tw), bw[ks], accw, 0, 0, 0);
                acca = __builtin_amdgcn_mfma_f32_16x16x32_bf16(__builtin_bit_cast(bf16x8, aw), ba[ks], acca, 0, 0, 0);
            }
#pragma unroll
            for (int j = 0; j < 4; ++j) {
                const int t = mt * 16 + q4 * 4 + j;
                const float xw = w0c + accw[j];
                const float nx = -xw; const float sp = fmaxf(nx, 0.f) + log1pf(__expf(-fabsf(nx)));
                const float wlog = -sp - 0.5f; const float dec = __expf(-__expf(wlog));
                const float av = sigmoidf_(a0c + acca[j]);
                const float kx = ZS[t * 320 + 64 + cl], rr = ZS[t * 320 + cl];
                OP[t * 320 + cl] = kx * kkc; OP[t * 320 + 64 + cl] = rr * dec; OP[t * 320 + 128 + cl] = dec; OP[t * 320 + 192 + cl] = av;
                OP[t * 320 + 256 + cl] = kx * (1.f + (av - 1.f) * kac);
            }
        }
        __syncthreads();
#pragma unroll
        for (int i = 0; i < 4; ++i) {
            const int t = wave * 4 + i;
            const float kr = OP[t * 320 + lane], av = OP[t * 320 + 192 + lane], kv = OP[t * 320 + 256 + lane], rr = ZS[t * 320 + lane];
            const float n2 = wave_sum(kr * kr); const float inv = 1.f / fmaxf(sqrtf(n2), 1e-12f);
            const float kk = kr * inv, bb = kk * av;
            const float c1 = wave_sum(bb * rr), c2 = wave_sum(kv * rr), bc = wave_sum(rr * kv * rkl);
            OP[t * 320 + lane] = kk; OP[t * 320 + 192 + lane] = bb;
            if (lane == 0) { CB[t * 4 + 0] = c1; CB[t * 4 + 1] = c2; CB[t * 4 + 2] = bc; }
        }
        __syncthreads();
        {
            const int hh = tid >> 8;
#pragma unroll
            for (int rep = 0; rep < 2; ++rep) {
                const int bi = hh + 2 * rep, b = bg * 4 + bi;
                float* wkv_out = A.out + OUT_WKVS + ((size_t)b * 8 + h) * 4096;
                float s0[8], s1[8];
#pragma unroll
                for (int i = 0; i < 4; ++i) { s0[i] = s0pre[rep][0][i]; s0[4 + i] = s0pre[rep][1][i]; s1[i] = s0pre[rep][2][i]; s1[4 + i] = s0pre[rep][3][i]; }
                for (int tt = 0; tt < 8; ++tt) {
                    const int t = bi * 8 + tt;
                    const LAS f32x4* op = (const LAS f32x4*)(OP + t * 320 + kq * 8);
                    float kk[8], rw[8], ww[8], bb[8], kv[8];
                    { f32x4 a = op[0], c = op[1]; kk[0] = a.x; kk[1] = a.y; kk[2] = a.z; kk[3] = a.w; kk[4] = c.x; kk[5] = c.y; kk[6] = c.z; kk[7] = c.w; }
                    { f32x4 a = op[16], c = op[17]; rw[0] = a.x; rw[1] = a.y; rw[2] = a.z; rw[3] = a.w; rw[4] = c.x; rw[5] = c.y; rw[6] = c.z; rw[7] = c.w; }
                    { f32x4 a = op[32], c = op[33]; ww[0] = a.x; ww[1] = a.y; ww[2] = a.z; ww[3] = a.w; ww[4] = c.x; ww[5] = c.y; ww[6] = c.z; ww[7] = c.w; }
                    { f32x4 a = op[48], c = op[49]; bb[0] = a.x; bb[1] = a.y; bb[2] = a.z; bb[3] = a.w; bb[4] = c.x; bb[5] = c.y; bb[6] = c.z; bb[7] = c.w; }
                    { f32x4 a = op[64], c = op[65]; kv[0] = a.x; kv[1] = a.y; kv[2] = a.z; kv[3] = a.w; kv[4] = c.x; kv[5] = c.y; kv[6] = c.z; kv[7] = c.w; }
                    const float v0 = ZS[t * 320 + 128 + vr], v1 = ZS[t * 320 + 128 + vr + 32];
                    const float c1 = CB[t * 4 + 0], c2 = CB[t * 4 + 1];
                    float sa0 = 0.f, sa1 = 0.f, yp0 = 0.f, yp1 = 0.f;
#pragma unroll
                    for (int i = 0; i < 8; ++i) { sa0 += s0[i] * kk[i]; sa1 += s1[i] * kk[i]; yp0 += s0[i] * rw[i]; yp1 += s1[i] * rw[i]; }
                    sa0 = red8_sum(sa0); sa1 = red8_sum(sa1); yp0 = red8_sum(yp0); yp1 = red8_sum(yp1);
#pragma unroll
                    for (int i = 0; i < 8; ++i) { s0[i] = s0[i] * ww[i] - sa0 * bb[i] + v0 * kv[i]; s1[i] = s1[i] * ww[i] - sa1 * bb[i] + v1 * kv[i]; }
                    if (kq == 0) { YB[t * 64 + vr] = yp0 - sa0 * c1 + v0 * c2; YB[t * 64 + vr + 32] = yp1 - sa1 * c1 + v1 * c2; }
                }
                float* w0p = wkv_out + vr * 64 + kq * 8; float* w1p = wkv_out + (vr + 32) * 64 + kq * 8;
                *(f32x4*)w0p = (f32x4){s0[0], s0[1], s0[2], s0[3]}; *(f32x4*)(w0p + 4) = (f32x4){s0[4], s0[5], s0[6], s0[7]};
                *(f32x4*)w1p = (f32x4){s1[0], s1[1], s1[2], s1[3]}; *(f32x4*)(w1p + 4) = (f32x4){s1[4], s1[5], s1[6], s1[7]};
            }
        }
        __syncthreads();
#pragma unroll
        for (int i = 0; i < 4; ++i) {
            const int t = wave * 4 + i;
            {
                const float y = YB[t * 64 + lane];
                const float mean = wave_sum(y) * (1.f / 64.f); const float d = y - mean; const float var = wave_sum(d * d) * (1.f / 64.f);
                const float yn = d * (__builtin_amdgcn_rsqf(var + GN_EPS)) * lnw + lnb;
                const float o = yn + CB[t * 4 + 2] * ZS[t * 320 + 128 + lane];
                const size_t row = (size_t)MP + (size_t)(bg * 4 + (t >> 3)) * 8 + (t & 7);
                const float g = bf2f(Z[row * NZ + O_GR + h * 64 + lane]);
                MIX[row * DM + h * 64 + lane] = (bf16_t)f2bf(o * siluf_(g));
            }
        }
        __syncthreads();
    }
    if (h == 0) { for (int c = tid; c < 4 * SHIFT; c += 512) { const int bi = c / SHIFT, cc = c % SHIFT, b = bg * 4 + bi; const size_t row = (size_t)MP + (size_t)b * 8 + 7;
        A.out[OUT_SHS + (size_t)b * SHIFT + cc] = bf2f(Z[row * NZ + cc]); } }
}
constexpr int CA_ZR = 0, CA_ZK = 16384, CA_ZV = 32768, CA_TH = 49152, CA_AD = 58368, CA_LW = 67584, CA_AA = 83968, CA_SEG = 100352, CA_G = 102400;
constexpr int CA_KKT = 0, CA_BT = 9216, CA_KT = 18432, CA_RT = 27648, CA_NBHT = 36864, CA_KHT = 46080, CA_VT = 55296, CA_RHS = 64512, CA_XT = 0,
              CA_N = 102656, CA_MAK = 119552, CA_NMRB = 128768, CA_MRK = 137984, NST = 66;

__device__ __forceinline__ float wsum_fast(float x) {
    x += dppf<0xB1>(x); x += dppf<0x4E>(x); x += dppf<0x141>(x); x += dppf<0x140>(x);
    const int xi = __builtin_bit_cast(int, x);
    return __builtin_bit_cast(float, __builtin_amdgcn_readlane(xi, 0)) + __builtin_bit_cast(float, __builtin_amdgcn_readlane(xi, 16)) +
           __builtin_bit_cast(float, __builtin_amdgcn_readlane(xi, 32)) + __builtin_bit_cast(float, __builtin_amdgcn_readlane(xi, 48));
}
__device__ __forceinline__ bf16x8 ldsfrag(const LAS unsigned char* base, int row, int kofs) { return *(const LAS bf16x8*)(base + row * 144 + kofs * 2); }
__device__ __forceinline__ u32x2 pack4(float a, float b, float c, float d) { u32x2 o; o.x = pk2(a, b); o.y = pk2(c, d); return o; }
#define MFMA16(a, b, c) __builtin_amdgcn_mfma_f32_16x16x32_bf16(a, b, c, 0, 0, 0)


struct HeadConstA { int h; bf16x8 bw[2][2], ba[2][2]; float w0c[2], a0c[2], kkc, kac, rkc; };
__device__ __forceinline__ void load_headconst(const Args& A, HeadConstA& H, int h, int tid, int lane, int wave) {
    const int fr = lane & 15, q4 = lane >> 4, nth = wave >> 2;
    const bf16_t* W2T = (const bf16_t*)(A.ws + WS_W2T); const bf16_t* A2T = (const bf16_t*)(A.ws + WS_A2T);
#pragma unroll
    for (int nn = 0; nn < 2; ++nn) { const int cgl = h * 64 + (nth * 2 + nn) * 16 + fr;
#pragma unroll
        for (int ks = 0; ks < 2; ++ks) { H.bw[nn][ks] = *(const bf16x8*)(W2T + cgl * 64 + ks * 32 + q4 * 8); H.ba[nn][ks] = *(const bf16x8*)(A2T + cgl * 64 + ks * 32 + q4 * 8); }
        H.w0c[nn] = A.w0[cgl]; H.a0c[nn] = A.a0[cgl]; }
    { const int cgl = h * 64 + lane; H.kkc = A.k_k[cgl]; H.kac = A.k_a[cgl]; H.rkc = A.r_k[cgl]; }
    H.h = h;
}

__device__ __forceinline__ void chunkA_item(const Args& A, LAS unsigned char* lds, int tid, int lane, int wave, int ci, int ci_next, HeadConstA& H) {
    const int c = ci & 31, h = (ci >> 5) & 7, b = ci >> 8;
    if (h != H.h) load_headconst(A, H, h, tid, lane, wave);
    const bf16_t* Z = (const bf16_t*)(A.ws + WS_Z);
    const size_t row0 = (size_t)b * SEQ + c * 64;
    const int fr = lane & 15, q4 = lane >> 4;
    {
        const int t = tid >> 3, part = tid & 7; const bool first = (c == 0 && t == 0);
        const bf16_t* zr = Z + (row0 + t) * NZ; const bf16_t* zp = zr - NZ;
#pragma unroll
        for (int s = 0; s < 5; ++s) {
            const int zcol = (s == 0 ? h * 64 : s == 1 ? 512 + h * 64 : s == 2 ? 1024 + h * 64 : s == 3 ? 1536 : 1600) + part * 8;
            const u32x4 cu = *(const u32x4*)(zr + zcol); u32x4 pu = {0u, 0u, 0u, 0u}; if (!first) pu = *(const u32x4*)(zp + zcol);
            const f32x4 m0 = *(const f32x4*)(A.mu + zcol), m1 = *(const f32x4*)(A.mu + zcol + 4);
            float cur[8], prv[8], o[8]; unpack8(cu, cur); unpack8(pu, prv);
            const float mu[8] = {m0.x, m0.y, m0.z, m0.w, m1.x, m1.y, m1.z, m1.w};
#pragma unroll
            for (int i = 0; i < 8; ++i) o[i] = cur[i] + mu[i] * (prv[i] - cur[i]);
            if (s < 3) { LAS f32x4* dst = (LAS f32x4*)(lds + s * 16384 + (t * 64 + part * 8) * 4); dst[0] = (f32x4){o[0], o[1], o[2], o[3]}; dst[1] = (f32x4){o[4], o[5], o[6], o[7]}; }
            else { if (s == 3) {
#pragma unroll
                    for (int i = 0; i < 8; ++i) o[i] = 1.f - 2.f * __builtin_amdgcn_rcpf(1.f + __expf(2.f * o[i])); }
                *(LAS u32x4*)(lds + (s == 3 ? CA_TH : CA_AD) + t * 144 + part * 16) = pack8(o); }
        }
    }
    LBAR();
    {
        const int mt = wave & 3, nth = wave >> 2;
        bf16x8 ath[2], aad[2];
#pragma unroll
        for (int ks = 0; ks < 2; ++ks) { ath[ks] = ldsfrag(lds + CA_TH, mt * 16 + fr, ks * 32 + q4 * 8); aad[ks] = ldsfrag(lds + CA_AD, mt * 16 + fr, ks * 32 + q4 * 8); }
#pragma unroll
        for (int nn = 0; nn < 2; ++nn) {
            const int cl = (nth * 2 + nn) * 16 + fr;
            f32x4 accw = {0.f, 0.f, 0.f, 0.f}, acca = {0.f, 0.f, 0.f, 0.f};
#pragma unroll
            for (int ks = 0; ks < 2; ++ks) { accw = MFMA16(ath[ks], H.bw[nn][ks], accw); acca = MFMA16(aad[ks], H.ba[nn][ks], acca); }
            const float w0c = H.w0c[nn], a0c = H.a0c[nn];
#pragma unroll
            for (int jj = 0; jj < 4; ++jj) { const int t = mt * 16 + q4 * 4 + jj;
                const float nx = -(w0c + accw[jj]); const float sp = fmaxf(nx, 0.f) + __logf(1.f + __expf(-fabsf(nx)));
                ((LAS float*)(lds + CA_LW))[t * 64 + cl] = -__expf(-sp - 0.5f);
                ((LAS float*)(lds + CA_AA))[t * 64 + cl] = sigmoidf_(a0c + acca[jj]); }
        }
    }
    LBAR();
    {
        const int cc = lane, seg = wave;
        float lwv[8], pre[8], zr[8], zk[8], zv[8], av[8];
#pragma unroll
        for (int i = 0; i < 8; ++i) { const int t = seg * 8 + i; lwv[i] = ((LAS float*)(lds + CA_LW))[t * 64 + cc]; zr[i] = ((LAS float*)(lds + CA_ZR))[t * 64 + cc];
            zk[i] = ((LAS float*)(lds + CA_ZK))[t * 64 + cc]; zv[i] = ((LAS float*)(lds + CA_ZV))[t * 64 + cc]; av[i] = ((LAS float*)(lds + CA_AA))[t * 64 + cc]; }
        pre[0] = lwv[0];
#pragma unroll
        for (int i = 1; i < 8; ++i) pre[i] = pre[i - 1] + lwv[i];
        ((LAS float*)(lds + CA_SEG))[seg * 64 + cc] = pre[7];
        LBAR();
        float off = 0.f, tot = 0.f;
#pragma unroll
        for (int s = 0; s < 8; ++s) { const float v = ((LAS float*)(lds + CA_SEG))[s * 64 + cc]; tot += v; if (s < seg) off += v; }
        const float kkc = H.kkc, kac = H.kac, rkc = H.rkc;
        float rhs8[8], nbh8[8], kh8[8];
        float* BCg = (float*)(A.ws + WS_BC) + (size_t)ci * 64;
#pragma unroll
        for (int i = 0; i < 8; ++i) { const int t = seg * 8 + i;
            const float lg = off + pre[i], lgp = lg - lwv[i];
            const float kkraw = zk[i] * kkc; const float n2 = wsum_fast(kkraw * kkraw); const float kk = kkraw * __builtin_amdgcn_rsqf(fmaxf(n2, 1e-24f));
            const float a = av[i], bb = kk * a, km = zk[i] * (1.f + (a - 1.f) * kac);
            const float bc = wsum_fast(zr[i] * km * rkc); if (lane == 0) BCg[t] = bc;
            const float e_in = __expf(lg), e_pr = __expf(lgp), e_out = __expf(-lg), e_h = __expf(tot - lg);
            const float kkt = kk * e_pr; rhs8[i] = kkt; nbh8[i] = -(bb * e_h); kh8[i] = km * e_h;
            *(LAS unsigned short*)(lds + CA_KKT + t * 144 + cc * 2) = (unsigned short)f2bf(kkt);
            *(LAS unsigned short*)(lds + CA_RT + t * 144 + cc * 2) = (unsigned short)f2bf(zr[i] * e_in);
            *(LAS unsigned short*)(lds + CA_BT + t * 144 + cc * 2) = (unsigned short)f2bf(bb * e_out);
            *(LAS unsigned short*)(lds + CA_KT + t * 144 + cc * 2) = (unsigned short)f2bf(km * e_out); }
        *(LAS u32x4*)(lds + CA_NBHT + cc * 144 + seg * 16) = pack8(nbh8); *(LAS u32x4*)(lds + CA_KHT + cc * 144 + seg * 16) = pack8(kh8); *(LAS u32x4*)(lds + CA_VT + cc * 144 + seg * 16) = pack8(zv);
        LAS f32x4* rp = (LAS f32x4*)(lds + CA_RHS + (cc * 68 + seg * 8) * 4); rp[0] = (f32x4){rhs8[0], rhs8[1], rhs8[2], rhs8[3]}; rp[1] = (f32x4){rhs8[4], rhs8[5], rhs8[6], rhs8[7]};
        if (seg == 0) ((LAS float*)(lds + CA_G))[cc] = __expf(tot);
    }
    LBAR();
    {
        const int og = wave >> 2, ms = wave & 3;
        const LAS unsigned char* Bsrc = lds + (og == 0 ? CA_KKT : CA_RT);
        bf16x8 aB[2], aK[2];
#pragma unroll
        for (int ks = 0; ks < 2; ++ks) { aB[ks] = ldsfrag(lds + CA_BT, ms * 16 + fr, ks * 32 + q4 * 8); aK[ks] = ldsfrag(lds + CA_KT, ms * 16 + fr, ks * 32 + q4 * 8); }
        LAS unsigned char* O1 = lds + (og == 0 ? CA_MAK : CA_MRK);
#pragma unroll
        for (int nt = 0; nt < 4; ++nt) {
            const int t = nt * 16 + fr, s0 = ms * 16 + q4 * 4;
            if (nt < ms) {
                *(LAS u32x2*)(O1 + t * 144 + s0 * 2) = (u32x2){0u, 0u};
                if (og == 1) *(LAS u32x2*)(lds + CA_NMRB + t * 144 + s0 * 2) = (u32x2){0u, 0u};
            } else {
                f32x4 acc1 = {0.f, 0.f, 0.f, 0.f}, acc2 = {0.f, 0.f, 0.f, 0.f};
#pragma unroll
                for (int ks = 0; ks < 2; ++ks) { const bf16x8 bb = ldsfrag(Bsrc, t, ks * 32 + q4 * 8); acc1 = MFMA16(aB[ks], bb, acc1); acc2 = MFMA16(aK[ks], bb, acc2); }
                float v1[4], v2[4];
#pragma unroll
                for (int jj = 0; jj < 4; ++jj) { const int s = s0 + jj; const bool ok = og == 0 ? (s < t) : (s <= t); v1[jj] = ok ? acc1[jj] : 0.f; v2[jj] = ok ? acc2[jj] : 0.f; }
                *(LAS u32x2*)(O1 + t * 144 + s0 * 2) = pack4(v2[0], v2[1], v2[2], v2[3]);
                if (og == 0) {
#pragma unroll
                    for (int jj = 0; jj < 4; ++jj) ((LAS float*)(lds + CA_N))[t * NST + jj * 16 + ms * 4 + q4] = v1[jj];
                } else *(LAS u32x2*)(lds + CA_NMRB + t * 144 + s0 * 2) = pack4(-v1[0], -v1[1], -v1[2], -v1[3]);
            }
        }
    }
    LBAR();
    {
        const int mt = wave >> 1;
        bf16x8 aM[2];
#pragma unroll
        for (int ks = 0; ks < 2; ++ks) aM[ks] = ldsfrag(lds + CA_MAK, mt * 16 + fr, ks * 32 + q4 * 8);
#pragma unroll
        for (int nn = 0; nn < 2; ++nn) { const int nt = (wave & 1) * 2 + nn; f32x4 acc = {0.f, 0.f, 0.f, 0.f};
#pragma unroll
            for (int ks = 0; ks < 2; ++ks) acc = MFMA16(aM[ks], ldsfrag(lds + CA_VT, nt * 16 + fr, ks * 32 + q4 * 8), acc);
            *(LAS f32x4*)(lds + CA_RHS + ((64 + nt * 16 + fr) * 68 + mt * 16 + q4 * 4) * 4) = acc; }
    }
    LBAR();
    if (tid < 256) {
        const int cp = tid >> 2, q = tid & 3;
        f32x2_t xa[8], xb[8];
#pragma unroll
        for (int m = 0; m < 8; ++m) { xa[m] = (f32x2_t){0.f, 0.f}; xb[m] = (f32x2_t){0.f, 0.f}; }
        const LAS float* Np = (const LAS float*)(lds + CA_N) + q * 16;
        const LAS float* Ra = (const LAS float*)(lds + CA_RHS) + cp * 68; const LAS float* Rb = Ra + 64 * 68;
        float a4[4], b4[4];
#pragma unroll
        for (int t = 0; t < 64; ++t) {
            f32x2_t sa = {0.f, 0.f}, sb = {0.f, 0.f};
#pragma unroll
            for (int p = 0; p < ((t + 3) / 4 + 1) / 2; ++p) { const f32x2_t nv = *(const LAS f32x2_t*)(Np + t * NST + 2 * p); sa += nv * xa[p]; sb += nv * xb[p]; }
            float ua = sa.x + sa.y, ub = sb.x + sb.y;
            ua += dppf<0xB1>(ua); ub += dppf<0xB1>(ub); ua += dppf<0x4E>(ua); ub += dppf<0x4E>(ub);
            const float xta = Ra[t] - ua, xtb = Rb[t] - ub;
            if (q == (t & 3)) { if ((t >> 2) & 1) { xa[t >> 3].y = xta; xb[t >> 3].y = xtb; } else { xa[t >> 3].x = xta; xb[t >> 3].x = xtb; } }
            a4[t & 3] = xta; b4[t & 3] = xtb;
            if ((t & 3) == 3 && q == 0) { *(LAS u32x2*)(lds + CA_XT + cp * 144 + (t - 3) * 2) = pack4(a4[0], a4[1], a4[2], a4[3]);
                *(LAS u32x2*)(lds + CA_XT + (64 + cp) * 144 + (t - 3) * 2) = pack4(b4[0], b4[1], b4[2], b4[3]); }
        }
    } else if (ci_next < 4096) {
        const int cn = ci_next & 31, hn = (ci_next >> 5) & 7, bn = ci_next >> 8; const long rown = (long)bn * SEQ + cn * 64 - 1;
        for (int l = tid - 256; l < 65 * 5; l += 256) { const int r = l / 5, sec = l % 5; long rr = rown + r; if (rr < 0) rr = 0;
            const bf16_t* p = Z + rr * NZ + (sec == 0 ? hn * 64 : sec == 1 ? 512 + hn * 64 : sec == 2 ? 1024 + hn * 64 : sec == 3 ? 1536 : 1600);
            unsigned dummy; asm volatile("global_load_dword %0, %1, off" : "=v"(dummy) : "v"(p) : "memory"); }
        asm volatile("s_waitcnt vmcnt(0)" ::: "memory");
    }
    LBAR();
    {
        const int mt = wave >> 1;
        unsigned char* pq = (unsigned char*)A.out + CH_PQ + (size_t)ci * 24576; bf16_t* PTg = (bf16_t*)pq; float* Qg = (float*)(pq + 8192);
        bf16_t* RHg = (bf16_t*)(A.ws + WS_RY + (size_t)ci * 16384); bf16_t* Y0g = RHg + 4096;
        bf16x8 aX[2], aV[2], aS[2];
#pragma unroll
        for (int ks = 0; ks < 2; ++ks) { aX[ks] = ldsfrag(lds + CA_XT, mt * 16 + fr, ks * 32 + q4 * 8); aV[ks] = ldsfrag(lds + CA_VT, mt * 16 + fr, ks * 32 + q4 * 8);
            aS[ks] = ldsfrag(lds + CA_XT, 64 + mt * 16 + fr, ks * 32 + q4 * 8); }
#pragma unroll
        for (int nn = 0; nn < 2; ++nn) { const int nt = (wave & 1) * 2 + nn, rn = nt * 16 + fr, r0 = mt * 16 + q4 * 4;
            bf16x8 bN[2], bK[2], bMb[2], bMk[2];
#pragma unroll
            for (int ks = 0; ks < 2; ++ks) { bN[ks] = ldsfrag(lds + CA_NBHT, rn, ks * 32 + q4 * 8); bK[ks] = ldsfrag(lds + CA_KHT, rn, ks * 32 + q4 * 8);
                bMb[ks] = ldsfrag(lds + CA_NMRB, rn, ks * 32 + q4 * 8); bMk[ks] = ldsfrag(lds + CA_MRK, rn, ks * 32 + q4 * 8); }
            f32x4 aP = {0.f, 0.f, 0.f, 0.f}, aQ = {0.f, 0.f, 0.f, 0.f}, aR = {0.f, 0.f, 0.f, 0.f}, aY = {0.f, 0.f, 0.f, 0.f};
#pragma unroll
            for (int ks = 0; ks < 2; ++ks) { aP = MFMA16(aX[ks], bN[ks], aP); aQ = MFMA16(aV[ks], bK[ks], aQ); aQ = MFMA16(aS[ks], bN[ks], aQ);
                aR = MFMA16(aX[ks], bMb[ks], aR); aY = MFMA16(aV[ks], bMk[ks], aY); aY = MFMA16(aS[ks], bMb[ks], aY); }
            const float gj = ((LAS float*)(lds + CA_G))[rn];
            *(u32x2*)(PTg + rn * 64 + r0) = pack4(aP[0] + (r0 + 0 == rn ? gj : 0.f), aP[1] + (r0 + 1 == rn ? gj : 0.f), aP[2] + (r0 + 2 == rn ? gj : 0.f), aP[3] + (r0 + 3 == rn ? gj : 0.f));
#pragma unroll
            for (int jj = 0; jj < 4; ++jj) Qg[(r0 + jj) * 64 + rn] = aQ[jj];
            { const u32x2 rt = *(const LAS u32x2*)(lds + CA_RT + rn * 144 + r0 * 2);
              *(u32x2*)(RHg + rn * 64 + r0) = pack4(bflo(rt.x) + aR[0], bfhi(rt.x) + aR[1], bflo(rt.y) + aR[2], bfhi(rt.y) + aR[3]); }
            *(u32x2*)(Y0g + rn * 64 + r0) = pack4(aY[0], aY[1], aY[2], aY[3]);
        }
    }
    LBAR();
}

constexpr int CB_SH = 0, CB_SL = 9216;
__device__ __forceinline__ void chunkB_item(const Args& A, LAS unsigned char* lds, int tid, int lane, int wave, int bh) {
    const int fr = lane & 15, q4 = lane >> 4, mt = wave >> 1, nt0 = (wave & 1) * 2, v0 = mt * 16 + q4 * 4;
    const int h = bh & 7, b = bh >> 3, colg = h * 64 + v0;
    const bf16_t* Z = (const bf16_t*)(A.ws + WS_Z); bf16_t* MIX = (bf16_t*)(A.ws + WS_XN);
    LAS float* ST = (LAS float*)(lds + 18432);
    f32x4 acc[2] = {{0.f, 0.f, 0.f, 0.f}, {0.f, 0.f, 0.f, 0.f}};
#define B_LOAD(BP, QV, cc) do { const size_t ci_ = (size_t)bh * 32 + (cc); const unsigned char* pq_ = (const unsigned char*)A.out + CH_PQ + ci_ * 24576; \
        const bf16_t* PTg_ = (const bf16_t*)pq_; const float* Qg_ = (const float*)(pq_ + 8192); \
        _Pragma("unroll") for (int nn = 0; nn < 2; ++nn) { const int rn = (nt0 + nn) * 16 + fr; \
            _Pragma("unroll") for (int ks = 0; ks < 2; ++ks) BP[nn][ks] = *(const bf16x8*)(PTg_ + rn * 64 + ks * 32 + q4 * 8); \
            _Pragma("unroll") for (int jj = 0; jj < 4; ++jj) QV[nn][jj] = Qg_[(mt * 16 + q4 * 4 + jj) * 64 + rn]; } } while (0)
#define B_LOADY(bR, y0_, zc_, zp_, zg_, bc_, cc) do { const size_t ci_ = (size_t)bh * 32 + (cc); \
        const bf16_t* RHg_ = (const bf16_t*)(A.ws + WS_RY + ci_ * 16384); const bf16_t* Y0g_ = RHg_ + 4096; const float* BCg_ = (const float*)(A.ws + WS_BC) + ci_ * 64; \
        _Pragma("unroll") for (int nn = 0; nn < 2; ++nn) { const int t = (nt0 + nn) * 16 + fr; const size_t row = (size_t)b * SEQ + (cc) * 64 + t; \
            _Pragma("unroll") for (int ks = 0; ks < 2; ++ks) bR[nn][ks] = *(const bf16x8*)(RHg_ + t * 64 + ks * 32 + q4 * 8); \
            y0_[nn] = *(const u32x2*)(Y0g_ + t * 64 + v0); zc_[nn] = *(const u32x2*)(Z + row * NZ + 1024 + colg); zp_[nn] = (u32x2){0u, 0u}; \
            if (!((cc) == 0 && t == 0)) zp_[nn] = *(const u32x2*)(Z + (row - 1) * NZ + 1024 + colg); \
            zg_[nn] = *(const u32x2*)(Z + row * NZ + O_GR + colg); bc_[nn] = BCg_[t]; } } while (0)
#define B_STEP(BP, QV, bR, y0_, zc_, zp_, zg_, bc_, cc) do { \
        const f32x4 lnw = *(const f32x4*)(A.ln_w + colg), lnb = *(const f32x4*)(A.ln_b + colg), muv = *(const f32x4*)(A.mu + 1024 + colg); \
        _Pragma("unroll") for (int nn = 0; nn < 2; ++nn) _Pragma("unroll") for (int jj = 0; jj < 4; ++jj) { const int v = mt * 16 + q4 * 4 + jj, i = (nt0 + nn) * 16 + fr; const float s_ = acc[nn][jj]; \
            const unsigned hi = pk2(s_, 0.f) & 0xffffu; const unsigned lo = pk2(s_ - bf2f(hi), 0.f) & 0xffffu; \
            *(LAS unsigned short*)(lds + CB_SH + v * 144 + i * 2) = (unsigned short)hi; *(LAS unsigned short*)(lds + CB_SL + v * 144 + i * 2) = (unsigned short)lo; } \
        LBAR(); \
        bf16x8 aH[2], aL[2]; \
        _Pragma("unroll") for (int ks = 0; ks < 2; ++ks) { aH[ks] = ldsfrag(lds + CB_SH, mt * 16 + fr, ks * 32 + q4 * 8); aL[ks] = ldsfrag(lds + CB_SL, mt * 16 + fr, ks * 32 + q4 * 8); } \
        float y_[2][4]; \
        _Pragma("unroll") for (int nn = 0; nn < 2; ++nn) { f32x4 an = QV[nn], ya = {0.f, 0.f, 0.f, 0.f}; \
            _Pragma("unroll") for (int ks = 0; ks < 2; ++ks) { an = MFMA16(aH[ks], BP[nn][ks], an); an = MFMA16(aL[ks], BP[nn][ks], an); ya = MFMA16(aH[ks], bR[nn][ks], ya); } \
            acc[nn] = an; const int t = (nt0 + nn) * 16 + fr; \
            y_[nn][0] = ya[0] + bflo(y0_[nn].x); y_[nn][1] = ya[1] + bfhi(y0_[nn].x); y_[nn][2] = ya[2] + bflo(y0_[nn].y); y_[nn][3] = ya[3] + bfhi(y0_[nn].y); \
            float s1 = (y_[nn][0] + y_[nn][1]) + (y_[nn][2] + y_[nn][3]), s2 = (y_[nn][0] * y_[nn][0] + y_[nn][1] * y_[nn][1]) + (y_[nn][2] * y_[nn][2] + y_[nn][3] * y_[nn][3]); \
            s1 += __shfl_xor(s1, 16); s1 += __shfl_xor(s1, 32); s2 += __shfl_xor(s2, 16); s2 += __shfl_xor(s2, 32); \
            if (q4 == 0) { ST[(mt * 64 + t) * 2] = s1; ST[(mt * 64 + t) * 2 + 1] = s2; } } \
        LBAR(); \
        _Pragma("unroll") for (int nn = 0; nn < 2; ++nn) { const int t = (nt0 + nn) * 16 + fr; float s1 = 0.f, s2 = 0.f; \
            _Pragma("unroll") for (int m = 0; m < 4; ++m) { s1 += ST[(m * 64 + t) * 2]; s2 += ST[(m * 64 + t) * 2 + 1]; } \
            const float mean = s1 * (1.f / 64.f); const float var = fmaxf(s2 * (1.f / 64.f) - mean * mean, 0.f); const float rstd = __builtin_amdgcn_rsqf(var + GN_EPS); \
            const size_t row = (size_t)b * SEQ + (cc) * 64 + t; \
            const float cv[4] = {bflo(zc_[nn].x), bfhi(zc_[nn].x), bflo(zc_[nn].y), bfhi(zc_[nn].y)}, pv[4] = {bflo(zp_[nn].x), bfhi(zp_[nn].x), bflo(zp_[nn].y), bfhi(zp_[nn].y)}, \
                        gv[4] = {bflo(zg_[nn].x), bfhi(zg_[nn].x), bflo(zg_[nn].y), bfhi(zg_[nn].y)}; \
            float o[4]; \
            _Pragma("unroll") for (int jj = 0; jj < 4; ++jj) { const float yn = (y_[nn][jj] - mean) * rstd * lnw[jj] + lnb[jj]; const float zsv = cv[jj] + muv[jj] * (pv[jj] - cv[jj]); \
                o[jj] = (yn + bc_[nn] * zsv) * siluf_(gv[jj]); } \
            *(u32x2*)(MIX + row * DM + colg) = pack4(o[0], o[1], o[2], o[3]); } } while (0)
    bf16x8 p0[2][2], p1[2][2]; f32x4 q0[2], q1[2];
    bf16x8 r0_[2][2], r1_[2][2]; u32x2 ya0[2], ya1[2], zc0[2], zc1[2], zp0[2], zp1[2], zg0[2], zg1[2]; float bc0[2], bc1[2];
    B_LOAD(p0, q0, 0); B_LOADY(r0_, ya0, zc0, zp0, zg0, bc0, 0);
#pragma unroll 1
    for (int c = 0; c < 32; ++c) {
        const int cn = c + 1 < 32 ? c + 1 : 31;
        B_LOAD(p1, q1, cn); B_LOADY(r1_, ya1, zc1, zp1, zg1, bc1, cn);
        B_STEP(p0, q0, r0_, ya0, zc0, zp0, zg0, bc0, c);
#pragma unroll
        for (int nn = 0; nn < 2; ++nn) { p0[nn][0] = p1[nn][0]; p0[nn][1] = p1[nn][1]; q0[nn] = q1[nn]; r0_[nn][0] = r1_[nn][0]; r0_[nn][1] = r1_[nn][1];
            ya0[nn] = ya1[nn]; zc0[nn] = zc1[nn]; zp0[nn] = zp1[nn]; zg0[nn] = zg1[nn]; bc0[nn] = bc1[nn]; }
    }
#undef B_LOAD
#undef B_LOADY
#undef B_STEP
    float* wo = A.out + OUT_WKVP + (size_t)bh * 4096;
#pragma unroll
    for (int nn = 0; nn < 2; ++nn)
#pragma unroll
        for (int jj = 0; jj < 4; ++jj) wo[(mt * 16 + q4 * 4 + jj) * 64 + (nt0 + nn) * 16 + fr] = acc[nn][jj];
    if ((bh & 7) == 0) { const size_t row = (size_t)b * SEQ + SEQ - 1; float* so = A.out + OUT_SHP + (size_t)b * SHIFT;
        for (int cix = tid; cix < SHIFT; cix += 512) so[cix] = bf2f(Z[row * NZ + cix]); }
    LBAR();
}

__device__ __forceinline__ void chunkC_item(const Args& A, LAS unsigned char* lds, int tid, int lane, int wave, int ci) {
    const int c = ci & 31, h = (ci >> 5) & 7, b = ci >> 8;
    const bf16_t* Z = (const bf16_t*)(A.ws + WS_Z); bf16_t* MIX = (bf16_t*)(A.ws + WS_XN);
    const int fr = lane & 15, q4 = lane >> 4, mt = wave >> 1, nt0 = (wave & 1) * 2, v0 = mt * 16 + q4 * 4;
    const bf16_t* Sg = (const bf16_t*)((const unsigned char*)A.out + CH_S + (size_t)ci * 8192);
    const bf16_t* RHg = (const bf16_t*)(A.ws + WS_RY + (size_t)ci * 16384); const bf16_t* Y0g = RHg + 4096;
    const float* BCg = (const float*)(A.ws + WS_BC) + (size_t)ci * 64;
    LAS float* ST = (LAS float*)lds;
    bf16x8 aS[2];
#pragma unroll
    for (int ks = 0; ks < 2; ++ks) aS[ks] = *(const bf16x8*)(Sg + (mt * 16 + fr) * 64 + ks * 32 + q4 * 8);
    const int colg = h * 64 + v0;
    u32x2 zcA[2], zpA[2], zgA[2]; float bcA[2];
#pragma unroll
    for (int nn = 0; nn < 2; ++nn) { const int t = (nt0 + nn) * 16 + fr; const size_t row = (size_t)b * SEQ + c * 64 + t;
        zcA[nn] = *(const u32x2*)(Z + row * NZ + 1024 + colg); zpA[nn] = (u32x2){0u, 0u}; if (!(c == 0 && t == 0)) zpA[nn] = *(const u32x2*)(Z + (row - 1) * NZ + 1024 + colg);
        zgA[nn] = *(const u32x2*)(Z + row * NZ + O_GR + colg); bcA[nn] = BCg[t]; }
    const f32x4 lnw = *(const f32x4*)(A.ln_w + colg), lnb = *(const f32x4*)(A.ln_b + colg), muv = *(const f32x4*)(A.mu + 1024 + colg);
    float y[2][4];
#pragma unroll
    for (int nn = 0; nn < 2; ++nn) { const int t = (nt0 + nn) * 16 + fr; f32x4 acc = {0.f, 0.f, 0.f, 0.f};
#pragma unroll
        for (int ks = 0; ks < 2; ++ks) acc = MFMA16(aS[ks], *(const bf16x8*)(RHg + t * 64 + ks * 32 + q4 * 8), acc);
        const u32x2 y0 = *(const u32x2*)(Y0g + t * 64 + v0);
        y[nn][0] = acc[0] + bflo(y0.x); y[nn][1] = acc[1] + bfhi(y0.x); y[nn][2] = acc[2] + bflo(y0.y); y[nn][3] = acc[3] + bfhi(y0.y);
        float s1 = (y[nn][0] + y[nn][1]) + (y[nn][2] + y[nn][3]), s2 = (y[nn][0] * y[nn][0] + y[nn][1] * y[nn][1]) + (y[nn][2] * y[nn][2] + y[nn][3] * y[nn][3]);
        s1 += __shfl_xor(s1, 16); s1 += __shfl_xor(s1, 32); s2 += __shfl_xor(s2, 16); s2 += __shfl_xor(s2, 32);
        if (q4 == 0) { ST[(mt * 64 + t) * 2] = s1; ST[(mt * 64 + t) * 2 + 1] = s2; } }
    LBAR();
#pragma unroll
    for (int nn = 0; nn < 2; ++nn) { const int t = (nt0 + nn) * 16 + fr; float s1 = 0.f, s2 = 0.f;
#pragma unroll
        for (int m = 0; m < 4; ++m) { s1 += ST[(m * 64 + t) * 2]; s2 += ST[(m * 64 + t) * 2 + 1]; }
        const float mean = s1 * (1.f / 64.f); const float var = fmaxf(s2 * (1.f / 64.f) - mean * mean, 0.f); const float rstd = __builtin_amdgcn_rsqf(var + GN_EPS);
        const size_t row = (size_t)b * SEQ + c * 64 + t;
        const u32x2 zc = zcA[nn], zp = zpA[nn], zg = zgA[nn];
        const float cv[4] = {bflo(zc.x), bfhi(zc.x), bflo(zc.y), bfhi(zc.y)}, pv[4] = {bflo(zp.x), bfhi(zp.x), bflo(zp.y), bfhi(zp.y)}, gv[4] = {bflo(zg.x), bfhi(zg.x), bflo(zg.y), bfhi(zg.y)};
        const float bc = bcA[nn]; float o[4];
#pragma unroll
        for (int jj = 0; jj < 4; ++jj) { const float yn = (y[nn][jj] - mean) * rstd * lnw[jj] + lnb[jj]; const float zsv = cv[jj] + muv[jj] * (pv[jj] - cv[jj]);
            o[jj] = (yn + bc * zsv) * siluf_(gv[jj]); }
        *(u32x2*)(MIX + row * DM + colg) = pack4(o[0], o[1], o[2], o[3]); }
    LBAR();
}

constexpr int AT_K = 0, AT_V = 36864, AT_P = 70656;
__device__ __forceinline__ void attn_prompt_item(const Args& A, LAS unsigned char* lds, int tid, int lane, int wave, int b, int nb, int kvh) {
    const bf16_t* Z = (const bf16_t*)(A.ws + WS_Z); bf16_t* MIX = (bf16_t*)(A.ws + WS_XN);
    const float* ct = (const float*)(A.ws + WS_ROPE); const float* st = ct + 2056 * 8;
    const int fr = lane & 15, q4 = lane >> 4;
    for (int idx = tid; idx < 2048; idx += 512) {
        const int key = idx & 255, ch = idx >> 8; const int pos = (nb - 1) * 128 + key;
        float kf[8], vf[8];
        if (pos >= 0) {
            const size_t row = (size_t)b * SEQ + pos; const bf16_t* kp = Z + row * NZ + O_K + kvh * 64;
            unpack8(*(const u32x4*)(kp + ch * 8), kf); unpack8(*(const u32x4*)(Z + row * NZ + O_V + kvh * 64 + ch * 8), vf);
            if (ch < 2) { float pf[8]; unpack8(*(const u32x4*)(kp + (ch ^ 1) * 8), pf);
#pragma unroll
                for (int i = 0; i < 8; ++i) { const float c = ct[pos * 8 + i], s = st[pos * 8 + i]; kf[i] = ch == 0 ? kf[i] * c - pf[i] * s : kf[i] * c + pf[i] * s; } }
            if (nb == NB - 1 && key >= 128) {
                float* ko = A.out + OUT_KP + ((size_t)(b * 128 + key - 128) * 2 + kvh) * 64 + ch * 8; float* vo = A.out + OUT_VP + ((size_t)(b * 128 + key - 128) * 2 + kvh) * 64 + ch * 8;
                *(f32x4*)ko = (f32x4){kf[0], kf[1], kf[2], kf[3]}; *(f32x4*)(ko + 4) = (f32x4){kf[4], kf[5], kf[6], kf[7]};
                *(f32x4*)vo = (f32x4){vf[0], vf[1], vf[2], vf[3]}; *(f32x4*)(vo + 4) = (f32x4){vf[4], vf[5], vf[6], vf[7]};
            }
        } else {
#pragma unroll
            for (int i = 0; i < 8; ++i) { kf[i] = 0.f; vf[i] = 0.f; }
        }
        *(LAS u32x4*)(lds + AT_K + key * 144 + ch * 16) = pack8(kf);
#pragma unroll
        for (int i = 0; i < 8; ++i) *(LAS unsigned short*)(lds + AT_V + (ch * 8 + i) * 528 + key * 2) = (unsigned short)f2bf(vf[i]);
    }
    __syncthreads();
    LAS unsigned char* Pw = lds + AT_P + wave * 2304;
    for (int task = wave; task < 16; task += 8) {
        const int g = task >> 2, tt = task & 3, hq = kvh * 4 + g;
        const float sink = A.sinks[hq] * 1.4426950408889634f;
        bf16x8 Qf[2][2];
#pragma unroll
        for (int mt = 0; mt < 2; ++mt)
#pragma unroll
            for (int ks = 0; ks < 2; ++ks) {
                const int tq = tt * 32 + mt * 16 + fr; const int pos = nb * 128 + tq; const size_t row = (size_t)b * SEQ + pos;
                const bf16_t* qp = Z + row * NZ + O_Q + hq * 64; const int d0 = ks * 32 + q4 * 8;
                float qf[8]; unpack8(*(const u32x4*)(qp + d0), qf);
                if (ks == 0 && q4 < 2) { float pf[8]; unpack8(*(const u32x4*)(qp + (d0 ^ 8)), pf);
#pragma unroll
                    for (int i = 0; i < 8; ++i) { const float c = ct[pos * 8 + i], s = st[pos * 8 + i]; qf[i] = q4 == 0 ? qf[i] * c - pf[i] * s : qf[i] * c + pf[i] * s; } }
#pragma unroll
                for (int i = 0; i < 8; ++i) qf[i] *= 0.18033688011112042f;
                Qf[mt][ks] = __builtin_bit_cast(bf16x8, pack8(qf));
            }
        float mrow[2][4], lrow[2][4]; f32x4 O[2][4];
#pragma unroll
        for (int mt = 0; mt < 2; ++mt) {
#pragma unroll
            for (int j = 0; j < 4; ++j) { mrow[mt][j] = sink; lrow[mt][j] = 1.f; }
#pragma unroll
            for (int dt = 0; dt < 4; ++dt) O[mt][dt] = (f32x4){0.f, 0.f, 0.f, 0.f};
        }
        unsigned short gts[2][4][4];
#pragma unroll
        for (int mt = 0; mt < 2; ++mt)
#pragma unroll
            for (int j = 0; j < 4; ++j) { const size_t row = (size_t)b * SEQ + nb * 128 + tt * 32 + mt * 16 + q4 * 4 + j;
#pragma unroll
                for (int dt = 0; dt < 4; ++dt) gts[mt][j][dt] = Z[row * NZ + O_GA + hq * 64 + dt * 16 + fr]; }
        int kc_lo = tt < 2 ? 0 : 1; const int kc_hi = kc_lo + 3; if (nb == 0 && kc_lo < 2) kc_lo = 2;
        for (int kc = kc_lo; kc < kc_hi; ++kc) {
#pragma unroll
            for (int mt = 0; mt < 2; ++mt) {
                f32x4 S[4];
#pragma unroll
                for (int nt = 0; nt < 4; ++nt) {
                    f32x4 acc = {0.f, 0.f, 0.f, 0.f};
#pragma unroll
                    for (int ks = 0; ks < 2; ++ks) { const bf16x8 Bk = *(const LAS bf16x8*)(lds + AT_K + (kc * 64 + nt * 16 + fr) * 144 + (ks * 32 + q4 * 8) * 2);
                        acc = __builtin_amdgcn_mfma_f32_16x16x32_bf16(Qf[mt][ks], Bk, acc, 0, 0, 0); }
                    S[nt] = acc;
                }
                float alpha[4];
#pragma unroll
                for (int j = 0; j < 4; ++j) {
                    const int dq = kc * 64 + fr - (tt * 32 + mt * 16 + q4 * 4 + j) - 1;
                    float mx = -1e30f;
#pragma unroll
                    for (int nt = 0; nt < 4; ++nt) { const bool ok = (unsigned)(dq + nt * 16) < 128u;
                        const float s = ok ? S[nt][j] : -1e30f; S[nt][j] = s; mx = fmaxf(mx, s); }
                    mx = red16_max(mx);
                    const float mn = fmaxf(mrow[mt][j], mx); alpha[j] = __builtin_amdgcn_exp2f(mrow[mt][j] - mn); mrow[mt][j] = mn;
                    float rs = 0.f;
#pragma unroll
                    for (int nt = 0; nt < 4; ++nt) { const float p = __builtin_amdgcn_exp2f(S[nt][j] - mn); S[nt][j] = p; rs += p; }
                    rs = red16_sum(rs); lrow[mt][j] = lrow[mt][j] * alpha[j] + rs;
                }
#pragma unroll
                for (int dt = 0; dt < 4; ++dt)
#pragma unroll
                    for (int j = 0; j < 4; ++j) O[mt][dt][j] *= alpha[j];
#pragma unroll
                for (int nt = 0; nt < 4; ++nt)
#pragma unroll
                    for (int j = 0; j < 4; ++j) *(LAS unsigned short*)(Pw + (q4 * 4 + j) * 144 + (nt * 16 + fr) * 2) = (unsigned short)f2bf(S[nt][j]);
                LDS_WAIT();
                bf16x8 Pa[2];
#pragma unroll
                for (int ks = 0; ks < 2; ++ks) Pa[ks] = *(const LAS bf16x8*)(Pw + fr * 144 + (ks * 32 + q4 * 8) * 2);
#pragma unroll
                for (int dt = 0; dt < 4; ++dt)
#pragma unroll
                    for (int ks = 0; ks < 2; ++ks) { const bf16x8 Bv = *(const LAS bf16x8*)(lds + AT_V + (dt * 16 + fr) * 528 + (kc * 64 + ks * 32 + q4 * 8) * 2);
                        O[mt][dt] = __builtin_amdgcn_mfma_f32_16x16x32_bf16(Pa[ks], Bv, O[mt][dt], 0, 0, 0); }
                LDS_WAIT();
            }
        }
#pragma unroll
        for (int mt = 0; mt < 2; ++mt)
#pragma unroll
            for (int j = 0; j < 4; ++j) {
                const int tq = tt * 32 + mt * 16 + q4 * 4 + j; const size_t row = (size_t)b * SEQ + nb * 128 + tq; const float il = __builtin_amdgcn_rcpf(lrow[mt][j]);
#pragma unroll
                for (int dt = 0; dt < 4; ++dt) { const int d = dt * 16 + fr; const float g = bf2f(gts[mt][j][dt]);
                    MIX[row * DM + 512 + hq * 64 + d] = (bf16_t)f2bf(O[mt][dt][j] * il * siluf_(g)); }
            }
    }
    __syncthreads();
}

constexpr int SA_K = 0, SA_V = 35456, SA_Q = 72448, SA_P = 80640;
__device__ __forceinline__ void attn_sample_item(const Args& A, LAS unsigned char* lds, int tid, int lane, int wave, int b, int kvh) {
    const bf16_t* Z = (const bf16_t*)(A.ws + WS_Z); bf16_t* MIX = (bf16_t*)(A.ws + WS_XN);
    const float* ct = (const float*)(A.ws + WS_ROPE); const float* st = ct + 2056 * 8;
    LAS float* SK = (LAS float*)(lds + SA_K); LAS float* SV = (LAS float*)(lds + SA_V); LAS float* SQ = (LAS float*)(lds + SA_Q); LAS float* SP = (LAS float*)(lds + SA_P);
    float* ko = A.out + OUT_KS + (size_t)b * 128 * 128; float* vo = A.out + OUT_VS + (size_t)b * 128 * 128;
    {
        f32x4 kq[4], vq[4];
#pragma unroll
        for (int i = 0; i < 4; ++i) { const int idx = tid + 512 * i, w = idx >> 4, d4 = (idx & 15) * 4; const size_t gi = ((size_t)(b * 128 + w) * 2 + kvh) * 64 + d4;
            kq[i] = *(const f32x4*)(A.cache_k + gi); vq[i] = *(const f32x4*)(A.cache_v + gi); }
#pragma unroll
        for (int i = 0; i < 4; ++i) { const int idx = tid + 512 * i, w = idx >> 4, d4 = (idx & 15) * 4;
            SK[w * 65 + d4] = kq[i].x; SK[w * 65 + d4 + 1] = kq[i].y; SK[w * 65 + d4 + 2] = kq[i].z; SK[w * 65 + d4 + 3] = kq[i].w;
            *(LAS f32x4*)(SV + w * 68 + d4) = vq[i];
            if (w >= 8) { *(f32x4*)(ko + ((w - 8) * 2 + kvh) * 64 + d4) = kq[i]; *(f32x4*)(vo + ((w - 8) * 2 + kvh) * 64 + d4) = vq[i]; } }
    }
    {
        const int t = tid >> 6, d = tid & 63; const size_t row = (size_t)MP + b * 8 + t; const bf16_t* kp = Z + row * NZ + O_K + kvh * 64;
        float kv = bf2f(kp[d]); const int pi = 2048 + t;
        if (d < 16) { const float pr = bf2f(kp[d ^ 8]); const float c = ct[pi * 8 + (d & 7)], s = st[pi * 8 + (d & 7)]; kv = d < 8 ? kv * c - pr * s : kv * c + pr * s; }
        const float vv = bf2f(Z[row * NZ + O_V + kvh * 64 + d]);
        SK[(128 + t) * 65 + d] = kv; SV[(128 + t) * 68 + d] = vv;
        ko[((120 + t) * 2 + kvh) * 64 + d] = kv; vo[((120 + t) * 2 + kvh) * 64 + d] = vv;
    }
    for (int idx = tid; idx < 32 * 64; idx += 512) {
        const int qi = idx >> 6, d = idx & 63, t = qi >> 2, g = qi & 3, hq = kvh * 4 + g; const size_t row = (size_t)MP + b * 8 + t; const bf16_t* qp = Z + row * NZ + O_Q + hq * 64;
        float qv = bf2f(qp[d]); const int pi = 2048 + t;
        if (d < 16) { const float pr = bf2f(qp[d ^ 8]); const float c = ct[pi * 8 + (d & 7)], s = st[pi * 8 + (d & 7)]; qv = d < 8 ? qv * c - pr * s : qv * c + pr * s; }
        SQ[qi * 64 + d] = qv * 0.125f;
    }
    __syncthreads();
    for (int idx = tid; idx < 32 * 136; idx += 512) {
        const int qi = idx / 136, ki = idx % 136, t = qi >> 2;
        const bool ok = ki < 128 ? (ki >= t + 1) : (ki - 128 <= t);
        float dot = 0.f;
#pragma unroll 8
        for (int d = 0; d < 64; ++d) dot += SQ[qi * 64 + d] * SK[ki * 65 + d];
        SP[qi * 136 + ki] = ok ? dot : -1e30f;
    }
    __syncthreads();
#pragma unroll
    for (int i = 0; i < 4; ++i) {
        const int qi = wave * 4 + i, g = qi & 3; const float sink = A.sinks[kvh * 4 + g];
        const float s0 = SP[qi * 136 + lane], s1 = SP[qi * 136 + 64 + lane], s2 = lane < 8 ? SP[qi * 136 + 128 + lane] : -1e30f;
        float mx = fmaxf(fmaxf(s0, s1), fmaxf(s2, sink));
#pragma unroll
        for (int o = 1; o < 64; o <<= 1) mx = fmaxf(mx, __shfl_xor(mx, o));
        const float p0 = __expf(s0 - mx), p1 = __expf(s1 - mx), p2 = __expf(s2 - mx);
        const float den = wave_sum(p0 + p1 + p2) + __expf(sink - mx); const float il = __builtin_amdgcn_rcpf(den);
        SP[qi * 136 + lane] = p0 * il; SP[qi * 136 + 64 + lane] = p1 * il; if (lane < 8) SP[qi * 136 + 128 + lane] = p2 * il;
    }
    __syncthreads();
    {
        const int qi = tid >> 4, d0 = (tid & 15) * 4, t = qi >> 2, g = qi & 3, hq = kvh * 4 + g;
        f32x4 acc = {0.f, 0.f, 0.f, 0.f};
        for (int k = 0; k < 136; ++k) { const float p = SP[qi * 136 + k]; const f32x4 v = *(const LAS f32x4*)(SV + k * 68 + d0); acc += p * v; }
        const size_t row = (size_t)MP + b * 8 + t;
#pragma unroll
        for (int e = 0; e < 4; ++e) { const float gte = bf2f(Z[row * NZ + O_GA + hq * 64 + d0 + e]); MIX[row * DM + 512 + hq * 64 + d0 + e] = (bf16_t)f2bf(acc[e] * siluf_(gte)); }
    }
    __syncthreads();
}


__device__ __forceinline__ void grid_bar(unsigned* cnt, unsigned target) {
    asm volatile("s_waitcnt vmcnt(0)" ::: "memory");
    __syncthreads();
    if (threadIdx.x == 0) {
        __builtin_amdgcn_fence(__ATOMIC_RELEASE, "agent");
        asm volatile("s_waitcnt vmcnt(0)" ::: "memory");
        __hip_atomic_fetch_add(cnt, 1u, __ATOMIC_RELAXED, __HIP_MEMORY_SCOPE_AGENT);
        while (__hip_atomic_load(cnt, __ATOMIC_RELAXED, __HIP_MEMORY_SCOPE_AGENT) < target) __builtin_amdgcn_s_sleep(1);
        __builtin_amdgcn_fence(__ATOMIC_ACQUIRE, "agent");
        asm volatile("s_waitcnt vmcnt(0)" ::: "memory");
    }
    __syncthreads();
}


__device__ __forceinline__ void small_gemm(const bf16_t* Ab, int lda, const bf16_t* Bt, int ldb, int K, int row0, int col0, int lane, int wave, f32x4 (&acc)[2]) {
    const int fr = lane & 15, q4 = lane >> 4, mt = wave >> 1, nt0 = (wave & 1) * 2;
    const bf16_t* ap = Ab + (size_t)(row0 + mt * 16 + fr) * lda + q4 * 8;
    const bf16_t* bp0 = Bt + (size_t)(col0 + nt0 * 16 + fr) * ldb + q4 * 8; const bf16_t* bp1 = bp0 + (size_t)16 * ldb;
    acc[0] = (f32x4){0.f, 0.f, 0.f, 0.f}; acc[1] = (f32x4){0.f, 0.f, 0.f, 0.f};
    for (int k = 0; k < K; k += 256) {
        bf16x8 a[8], b0[8], b1[8];
#pragma unroll
        for (int i = 0; i < 8; ++i) { a[i] = *(const bf16x8*)(ap + k + 32 * i); b0[i] = *(const bf16x8*)(bp0 + k + 32 * i); b1[i] = *(const bf16x8*)(bp1 + k + 32 * i); }
        __builtin_amdgcn_sched_barrier(0);
#pragma unroll
        for (int i = 0; i < 8; ++i) { acc[0] = MFMA16(a[i], b0[i], acc[0]); acc[1] = MFMA16(a[i], b1[i], acc[1]); }
        __builtin_amdgcn_sched_barrier(0);
    }
}

__global__ void __launch_bounds__(512, 2) hymba_fwd(Args A) {
    extern __shared__ __attribute__((aligned(16))) unsigned char lds_raw[];
    LAS unsigned char* lds = (LAS unsigned char*)lds_raw;
    cg::grid_group grid = cg::this_grid();
    const int tid = threadIdx.x, lane = tid & 63, wave = __builtin_amdgcn_readfirstlane(tid >> 6);
    unsigned char* ws = A.ws;
    unsigned* ctl = (unsigned*)(ws + WS_CTL);
    float* rowss2 = (float*)(ctl + CW_SS2); float* rowss3 = (float*)(ctl + CW_SS3);
    bf16_t* Win_t = (bf16_t*)(ws + WS_WIN); bf16_t* Wout_t = (bf16_t*)(ws + WS_WOUT); bf16_t* Wpg_t = (bf16_t*)(ws + WS_WPG); bf16_t* Wpp_t = (bf16_t*)(ws + WS_WPP);
    bf16_t* XN = (bf16_t*)(ws + WS_XN); bf16_t* PB = (bf16_t*)(ws + WS_PB); bf16_t* PP = (bf16_t*)(ws + WS_PP); bf16_t* Zb = (bf16_t*)(ws + WS_Z);
    bf16_t* MIX = XN; bf16_t* H2B = Zb;

    unsigned bar_k = 0u;
#ifndef NO_P0
    p0_prologue(A, lds, tid, lane, wave);
#endif
    grid.sync();
#ifndef NO_P1
    {
        pg8::Gemm g{XN, Win_t, MTOT, NZ, DM}; pg8::StaticOrder S; S.init(MTOT, NZ, (int)gridDim.x, (int)blockIdx.x);
        pg8::EpiBf16 E{Zb, NZ};
        pg8::gemm_phase<pg8::EpiBf16, pg8::StaticOrder, true, true>(lds, g, S, E);
    }
    {
        const int G = (int)gridDim.x, tail = ((MTOT / 256) * (NZ / 256)) % G;
        pg8::Gemm g{PB, Wpp_t, MTOT, DM, PLE}; pg8::StaticOrder S;
        if (tail * 2 < G) S.init(MTOT, DM, G - tail, (int)blockIdx.x >= tail ? (int)blockIdx.x - tail : (1 << 28)); else S.init(MTOT, DM, G, (int)blockIdx.x);
        pg8::EpiBf16 E{PP, DM};
        pg8::gemm_phase<pg8::EpiBf16, pg8::StaticOrder, true, true>(lds, g, S, E);
    }
#endif
    grid_bar(ctl + CW_BAR, (unsigned)gridDim.x * (++bar_k));
#ifndef NO_P2
    {
        LAS int* s_item = (LAS int*)(lds + LDS_BYTES - 16);
        constexpr int N_CH = 4096, N_PB = 128, N_PA = 512, N_SA = 256, N_SS = 1024;
        { HeadConstA HC; HC.h = -1;
          for (int it = blockIdx.x; it < N_CH; it += gridDim.x) chunkA_item(A, lds, tid, lane, wave, it, it + (int)gridDim.x, HC); }
        grid_bar(ctl + CW_BAR, (unsigned)gridDim.x * (++bar_k));
        for (;;) {
            if (tid == 0) *s_item = (int)atomicAdd(ctl + CW_WORK + 1, 1u);
            __syncthreads();
            const int it = *s_item;
            __syncthreads();
            if (it >= N_PB) break;
            chunkB_item(A, lds, tid, lane, wave, it);
        }
        for (;;) {
            if (tid == 0) *s_item = (int)atomicAdd(ctl + CW_WORK + 2, 1u);
            __syncthreads();
            const int r = *s_item;
            __syncthreads();
            if (r >= 256) break;
            sscan_item(A, lds, tid, lane, wave, r >> 3, r & 7);
        }
        for (;;) {
            if (tid == 0) *s_item = (int)atomicAdd(ctl + CW_WORK + 3, 1u);
            __syncthreads();
            const int r = *s_item;
            __syncthreads();
            if (r >= N_PA) break;
            const int kvh = r & 1, nb = (r >> 1) & 15, b = r >> 5;
            attn_prompt_item(A, lds, tid, lane, wave, b, nb, kvh);
        }
        for (;;) {
            if (tid == 0) *s_item = (int)atomicAdd(ctl + CW_WORK + 4, 1u);
            __syncthreads();
            const int r = *s_item;
            __syncthreads();
            if (r >= N_SA) break;
            attn_sample_item(A, lds, tid, lane, wave, r >> 1, r & 1);
        }
    }
#endif
    grid_bar(ctl + CW_BAR, (unsigned)gridDim.x * (++bar_k));
#ifndef NO_P3
    {
        pg8::Gemm g{MIX, Wout_t, MP, DM, DM}; pg8::StaticOrder S; S.init(MP, DM, (int)gridDim.x, (int)blockIdx.x);
        pg8::EpiRes E{A.x_prompt, A.x_sample, A.out, H2B, rowss2};
        pg8::gemm_phase<pg8::EpiRes, pg8::StaticOrder, true, true>(lds, g, S, E);
    }
    {
        const int fr = lane & 15, q4 = lane >> 4;
        for (int tile = blockIdx.x; tile < 256; tile += gridDim.x) {
            const int row0 = MP + (tile >> 4) * 64, col0 = (tile & 15) * 64; f32x4 acc[2];
            small_gemm(MIX, DM, Wout_t, DM, DM, row0, col0, lane, wave, acc);
#pragma unroll
            for (int jj = 0; jj < 4; ++jj) { const int row = row0 + (wave >> 1) * 16 + q4 * 4 + jj; float ss = 0.f;
#pragma unroll
                for (int nn = 0; nn < 2; ++nn) { const int col = col0 + ((wave & 1) * 2 + nn) * 16 + fr; const float v = acc[nn][jj] + A.x_sample[(size_t)(row - MP) * DM + col];
                    H2B[(size_t)row * DM + col] = (bf16_t)f2bf(v); ss += v * v; }
                ss = red16_sum(ss); if (fr == 0) atomicAdd(rowss2 + row, ss); }
        }
    }
#endif
    grid_bar(ctl + CW_BAR, (unsigned)gridDim.x * (++bar_k));
#ifndef NO_P4
    {
        pg8::Gemm g{H2B, Wpg_t, MP, DM, DM}; pg8::StaticOrder S; S.init(MP, DM, (int)gridDim.x, (int)blockIdx.x);
        pg8::EpiGate E{H2B, XN, PP, rowss2, rowss3};
        pg8::gemm_phase<pg8::EpiGate, pg8::StaticOrder, true, true>(lds, g, S, E);
    }
    {
        const int fr = lane & 15, q4 = lane >> 4;
        for (int tile = blockIdx.x; tile < 256; tile += gridDim.x) {
            const int row0 = MP + (tile >> 4) * 64, col0 = (tile & 15) * 64; f32x4 acc[2];
            small_gemm(H2B, DM, Wpg_t, DM, DM, row0, col0, lane, wave, acc);
#pragma unroll
            for (int jj = 0; jj < 4; ++jj) { const int row = row0 + (wave >> 1) * 16 + q4 * 4 + jj; float ss = 0.f;
                const float rstd = __builtin_amdgcn_rsqf(rowss2[row] * (1.f / DM) + NORM_EPS);
#pragma unroll
                for (int nn = 0; nn < 2; ++nn) { const int col = col0 + ((wave & 1) * 2 + nn) * 16 + fr; const size_t o = (size_t)row * DM + col;
                    const float v = bf2f(H2B[o]) + sigmoidf_(acc[nn][jj] * rstd) * bf2f(PP[o]); XN[o] = (bf16_t)f2bf(v); ss += v * v; }
                ss = red16_sum(ss); if (fr == 0) atomicAdd(rowss3 + row, ss); }
        }
    }
#endif
    grid_bar(ctl + CW_BAR, (unsigned)gridDim.x * (++bar_k));
    {
        const int gw = blockIdx.x * 8 + wave, NGW = gridDim.x * 8;
        f32x4 gv[4];
#pragma unroll
        for (int j = 0; j < 4; ++j) gv[j] = *((const f32x4*)A.g_final + lane + 64 * j);
        u32x2 hw[4], nh[4]; float rs = 0.f, nrs = 0.f;
        int m = gw;
        if (m < MTOT) { const u32x2* hr = (const u32x2*)(XN + (size_t)m * DM) + lane;
#pragma unroll
            for (int j = 0; j < 4; ++j) hw[j] = hr[64 * j];
            rs = rowss3[m]; }
        for (; m < MTOT; m += NGW) {
            const int mn = m + NGW;
            if (mn < MTOT) { const u32x2* hr = (const u32x2*)(XN + (size_t)mn * DM) + lane;
#pragma unroll
                for (int j = 0; j < 4; ++j) nh[j] = hr[64 * j];
                nrs = rowss3[mn]; }
            const float rstd = __builtin_amdgcn_rsqf(rs * (1.f / DM) + NORM_EPS);
            f32x4* yr = (f32x4*)(A.out + (size_t)m * DM) + lane;
#pragma unroll
            for (int j = 0; j < 4; ++j) { f32x4 v = {bflo(hw[j].x), bfhi(hw[j].x), bflo(hw[j].y), bfhi(hw[j].y)}; v = v * rstd * gv[j]; yr[64 * j] = v; }
#pragma unroll
            for (int j = 0; j < 4; ++j) hw[j] = nh[j];
            rs = nrs;
        }
    }
}

extern "C" void kernel_launch(void* const* d_in, const int* in_sizes, int n_in, void* d_out, int out_size, void* d_ws, size_t ws_size, hipStream_t stream) {
    static int grid = 0;
    if (grid == 0) {
        if (n_in != 26 || ws_size < WS_END) { fprintf(stderr, "kernel_launch: unexpected n_in %d / ws %zu\n", n_in, ws_size); grid = -1; return; }
        int dev = 0, cus = 0, per_cu = 0;
        (void)hipGetDevice(&dev); (void)hipDeviceGetAttribute(&cus, hipDeviceAttributeMultiprocessorCount, dev);
        if (hipFuncSetAttribute((const void*)hymba_fwd, hipFuncAttributeMaxDynamicSharedMemorySize, LDS_BYTES) != hipSuccess) { fprintf(stderr, "kernel_launch: hipFuncSetAttribute failed\n"); grid = -1; return; }
        if (hipOccupancyMaxActiveBlocksPerMultiprocessor(&per_cu, (const void*)hymba_fwd, 512, LDS_BYTES) != hipSuccess || per_cu < 1) { fprintf(stderr, "kernel_launch: occupancy query says %d\n", per_cu); per_cu = 1; }
        (void)hipGetLastError();
        grid = cus * 1;
        if (grid <= 0) grid = 256;
    }
    if (grid < 0) return;
    Args a{};
    const float** pa = (const float**)&a;
    for (int i = 0; i < 26; ++i) pa[i] = (const float*)d_in[i];
    a.out = (float*)d_out; a.ws = (unsigned char*)d_ws;
    void* args[] = {&a};
    hipError_t e = hipLaunchCooperativeKernel((const void*)hymba_fwd, dim3(grid), dim3(512), args, LDS_BYTES, stream);
    if (e != hipSuccess) fprintf(stderr, "cooperative launch failed: %s (grid %d)\n", hipGetErrorString(e), grid);
}
```

```cpp
#include <hip/hip_runtime.h>
#include <hip/hip_cooperative_groups.h>
#include <cstdio>
#include <cstdint>
namespace cg = cooperative_groups;

constexpr int DM = 1024, MP = 32768, MS = 1024, MTOT = MP + MS, SEQ = 2048, NB = 16, DB = 128, DSEQ = 8;
constexpr int NZ = 3584;
constexpr int IN_DIM = 3456, SHIFT = 1664, PLE = 256;
constexpr int O_GR = 1664, O_Q = 2176, O_K = 2688, O_V = 2816, O_GA = 2944;
constexpr float NORM_EPS = 1e-6f, GN_EPS = 64e-5f;
constexpr size_t OUT_Y = 0, OUT_WKVP = (size_t)MTOT * DM, OUT_SHP = OUT_WKVP + 16 * 8 * 4096, OUT_KP = OUT_SHP + 16 * SHIFT,
                 OUT_VP = OUT_KP + 16 * 128 * 128, OUT_WKVS = OUT_VP + 16 * 128 * 128, OUT_SHS = OUT_WKVS + (size_t)128 * 8 * 4096,
                 OUT_KS = OUT_SHS + 128 * SHIFT, OUT_VS = OUT_KS + (size_t)128 * 128 * 128;
constexpr size_t MiB = 1u << 20;
constexpr size_t WS_CTL = 0, CTL_BYTES = 1 * MiB;
constexpr size_t WS_WIN = 1 * MiB;
constexpr size_t WS_WOUT = 8 * MiB, WS_WPG = 10 * MiB, WS_WPP = 12 * MiB;
constexpr size_t WS_ROPE = 13 * MiB;
constexpr size_t WS_XN = 14 * MiB;
constexpr size_t WS_PB = 80 * MiB;
constexpr size_t WS_PP = 97 * MiB;
constexpr size_t WS_Z = 163 * MiB;
constexpr size_t CH_PQ = 0;
constexpr size_t CH_S = 96 * MiB;
constexpr size_t WS_RY = 395 * MiB;
constexpr size_t WS_BC = 459 * MiB;
constexpr size_t WS_W2T = 13 * MiB + 512 * 1024, WS_A2T = 13 * MiB + 640 * 1024;
constexpr size_t WS_END = 461 * MiB;
constexpr int CW_BAR = 512, CW_WORK = 0, CW_SS2 = 1024, CW_SS3 = CW_SS2 + MTOT;
constexpr int LDS_BYTES = 147456;

#define LAS __attribute__((address_space(3)))
typedef unsigned short bf16_t;
typedef short bf16x8 __attribute__((ext_vector_type(8)));
typedef float f32x4 __attribute__((ext_vector_type(4)));
typedef unsigned u32x4 __attribute__((ext_vector_type(4)));
typedef unsigned u32x2 __attribute__((ext_vector_type(2)));

typedef float f32x2_t __attribute__((ext_vector_type(2)));
typedef __bf16 bf16x2_t __attribute__((ext_vector_type(2)));
__device__ __forceinline__ unsigned pk2(float lo, float hi) { f32x2_t v = {lo, hi}; bf16x2_t b = __builtin_convertvector(v, bf16x2_t); return __builtin_bit_cast(unsigned, b); }
__device__ __forceinline__ unsigned f2bf(float f) { return pk2(f, 0.f) & 0xffffu; }
__device__ __forceinline__ float bf2f(unsigned h) { return __builtin_bit_cast(float, h << 16); }
__device__ __forceinline__ float bflo(unsigned u) { return __builtin_bit_cast(float, u << 16); }
__device__ __forceinline__ float bfhi(unsigned u) { return __builtin_bit_cast(float, u & 0xffff0000u); }
__device__ __forceinline__ void unpack8(u32x4 u, float* f) { f[0] = bflo(u.x); f[1] = bfhi(u.x); f[2] = bflo(u.y); f[3] = bfhi(u.y); f[4] = bflo(u.z); f[5] = bfhi(u.z); f[6] = bflo(u.w); f[7] = bfhi(u.w); }
__device__ __forceinline__ u32x4 pack8(const float* f) { u32x4 o; o.x = pk2(f[0], f[1]); o.y = pk2(f[2], f[3]); o.z = pk2(f[4], f[5]); o.w = pk2(f[6], f[7]); return o; }
__device__ __forceinline__ float wave_sum(float v) {
#pragma unroll
    for (int o = 1; o < 64; o <<= 1) v += __shfl_xor(v, o);
    return v;
}
template <int CTRL> __device__ __forceinline__ float dppf(float x) { return __builtin_bit_cast(float, __builtin_amdgcn_update_dpp(0, __builtin_bit_cast(int, x), CTRL, 0xf, 0xf, false)); }
__device__ __forceinline__ float red8_sum(float x) { x += dppf<0xB1>(x); x += dppf<0x4E>(x); x += dppf<0x141>(x); return x; }
__device__ __forceinline__ float red16_sum(float x) { x = red8_sum(x); x += dppf<0x140>(x); return x; }
__device__ __forceinline__ float red16_max(float x) { x = fmaxf(x, dppf<0xB1>(x)); x = fmaxf(x, dppf<0x4E>(x)); x = fmaxf(x, dppf<0x141>(x)); x = fmaxf(x, dppf<0x140>(x)); return x; }
__device__ __forceinline__ float sigmoidf_(float x) { return __builtin_amdgcn_rcpf(1.f + __expf(-x)); }
__device__ __forceinline__ float siluf_(float x) { return x * __builtin_amdgcn_rcpf(1.f + __expf(-x)); }
#define LDS_WAIT() asm volatile("s_waitcnt lgkmcnt(0)" ::: "memory")
#define LBAR() asm volatile("s_waitcnt lgkmcnt(0)\n\ts_barrier" ::: "memory")

namespace pg8 {
constexpr int BM = 256, BK = 64, HALF = 128, HTB = HALF * BK * 2  , STAGE_BYTES = 8 * HTB, NXCD = 8, WGM = 8;

__host__ __device__ __forceinline__ int lds_byte(int r, int c) { const int st = (r >> 4) * 2 + (c >> 5), rr = r & 15, cc = c & 31, ob = rr * 64 + cc * 2; return st * 1024 + (ob ^ (((ob >> 9) & 1) << 5)); }
__host__ __device__ __forceinline__ void stage_rc(int b, int& R, int& C) { const int st = b / 1024, sb = b % 1024, swz = sb ^ (((sb >> 9) & 1) << 5); R = (st >> 1) * 16 + swz / 64; C = (st & 1) * 32 + (swz % 64) / 2; }
__host__ __device__ __forceinline__ int perm32(int rho) { const int n = rho >> 4, i = rho & 15; return 8 * (i >> 2) + 4 * n + (i & 3); }

struct Unit { int pm, pn; };
struct Gemm { const bf16_t* A; const bf16_t* Bt; int M, N, K; };

struct StaticOrder {
    int nM, nN, nwg, G, c;
    __host__ __device__ void init(int M, int N, int G_, int c_) { nM = M / BM; nN = N / BM; nwg = nM * nN; G = G_; c = c_; }
    __host__ __device__ bool next(int i, Unit& u) const {
        const long L = (long)i * G + c; if (L >= nwg) return false;
        int wgid = (int)L; { const int q = nwg / NXCD, r = nwg % NXCD, xcd = wgid % NXCD, off = wgid / NXCD; wgid = (xcd < r ? xcd * (q + 1) : r * (q + 1) + (xcd - r) * q) + off; }
        const int nig = WGM * nN, gid = wgid / nig, fm = gid * WGM, gsz = (nM - fm) < WGM ? (nM - fm) : WGM;
        u.pm = fm + ((wgid % nig) % gsz); u.pn = (wgid % nig) / gsz; return true;
    }
    __device__ __forceinline__ void a_ready(const Unit&) const {}
    __device__ __forceinline__ void done(const Unit&) const {}
};

__device__ __forceinline__ unsigned cvt_pk_bf16(float lo, float hi) { unsigned r; asm volatile("v_cvt_pk_bf16_f32 %0, %1, %2" : "=v"(r) : "v"(lo), "v"(hi)); return r; }

struct EpiBf16 {
    static constexpr bool PERM = true, AFTER_DRAIN = false;
    bf16_t* O; int ldc;
    __device__ __forceinline__ void operator()(const f32x4 (&acc)[2][2][4][2], const Unit& u, int wr, int wc, int fr, int fq) const {
        const int row0 = u.pm * BM + wr * 64 + fr; const int col0 = u.pn * BM + wc * 32 + 8 * fq;
#pragma unroll
        for (int ai = 0; ai < 2; ++ai)
#pragma unroll
            for (int m = 0; m < 4; ++m) { bf16_t* rowp = O + (size_t)(row0 + ai * HALF + m * 16) * ldc + col0;
#pragma unroll
                for (int bj = 0; bj < 2; ++bj) { const f32x4 v0 = acc[ai][bj][m][0], v1 = acc[ai][bj][m][1];
                    u32x4 w; w.x = cvt_pk_bf16(v0[0], v0[1]); w.y = cvt_pk_bf16(v0[2], v0[3]); w.z = cvt_pk_bf16(v1[0], v1[1]); w.w = cvt_pk_bf16(v1[2], v1[3]);
                    *(u32x4*)(rowp + bj * HALF) = w; } }
    }
};

struct EpiRes {
    static constexpr bool PERM = true, AFTER_DRAIN = false;
    const float* xp; const float* xs; float* out; bf16_t* h2b; float* rowss;
    __device__ __forceinline__ void operator()(const f32x4 (&acc)[2][2][4][2], const Unit& u, int wr, int wc, int fr, int fq) const {
        const int row0 = u.pm * BM + wr * 64 + fr; const int col0 = u.pn * BM + wc * 32 + 8 * fq;
#pragma unroll
        for (int ai = 0; ai < 2; ++ai)
#pragma unroll
            for (int m = 0; m < 4; ++m) { const int row = row0 + ai * HALF + m * 16;
                const float* xr = (row < MP ? xp + (size_t)row * DM : xs + (size_t)(row - MP) * DM) + col0;
                bf16_t* brow = h2b + (size_t)row * DM + col0; float ss = 0.f;
#pragma unroll
                for (int bj = 0; bj < 2; ++bj) { const f32x4 x0 = *(const f32x4*)(xr + bj * HALF), x1 = *(const f32x4*)(xr + bj * HALF + 4);
                    const f32x4 v0 = acc[ai][bj][m][0] + x0, v1 = acc[ai][bj][m][1] + x1;
                    u32x4 w; w.x = cvt_pk_bf16(v0[0], v0[1]); w.y = cvt_pk_bf16(v0[2], v0[3]); w.z = cvt_pk_bf16(v1[0], v1[1]); w.w = cvt_pk_bf16(v1[2], v1[3]);
                    *(u32x4*)(brow + bj * HALF) = w;
                    ss += v0[0] * v0[0] + v0[1] * v0[1] + v0[2] * v0[2] + v0[3] * v0[3] + v1[0] * v1[0] + v1[1] * v1[1] + v1[2] * v1[2] + v1[3] * v1[3]; }
                ss += __shfl_xor(ss, 16); ss += __shfl_xor(ss, 32);
                if (fq == 0) atomicAdd(rowss + row, ss); }
    }
};

struct EpiGate {
    static constexpr bool PERM = true, AFTER_DRAIN = false;
    const bf16_t* h2b; bf16_t* h3b; const bf16_t* pp; const float* rowss2; float* rowss3;
    __device__ __forceinline__ void operator()(const f32x4 (&acc)[2][2][4][2], const Unit& u, int wr, int wc, int fr, int fq) const {
        const int row0 = u.pm * BM + wr * 64 + fr; const int col0 = u.pn * BM + wc * 32 + 8 * fq;
#pragma unroll
        for (int ai = 0; ai < 2; ++ai)
#pragma unroll
            for (int m = 0; m < 4; ++m) { const int row = row0 + ai * HALF + m * 16;
                const float rstd = __builtin_amdgcn_rsqf(rowss2[row] * (1.f / DM) + NORM_EPS);
                const bf16_t* hrow = h2b + (size_t)row * DM + col0; bf16_t* orow = h3b + (size_t)row * DM + col0; const bf16_t* prow = pp + (size_t)row * DM + col0; float ss = 0.f;
#pragma unroll
                for (int bj = 0; bj < 2; ++bj) { const u32x4 hw = *(const u32x4*)(hrow + bj * HALF); float hf[8]; unpack8(hw, hf);
                    const u32x4 pw = *(const u32x4*)(prow + bj * HALF); float pf[8]; unpack8(pw, pf);
                    const f32x4 a0 = acc[ai][bj][m][0], a1 = acc[ai][bj][m][1]; f32x4 v0, v1;
#pragma unroll
                    for (int e = 0; e < 4; ++e) { v0[e] = hf[e] + sigmoidf_(a0[e] * rstd) * pf[e]; v1[e] = hf[4 + e] + sigmoidf_(a1[e] * rstd) * pf[4 + e]; }
                    u32x4 w; w.x = cvt_pk_bf16(v0[0], v0[1]); w.y = cvt_pk_bf16(v0[2], v0[3]); w.z = cvt_pk_bf16(v1[0], v1[1]); w.w = cvt_pk_bf16(v1[2], v1[3]);
                    *(u32x4*)(orow + bj * HALF) = w;
                    ss += v0[0] * v0[0] + v0[1] * v0[1] + v0[2] * v0[2] + v0[3] * v0[3] + v1[0] * v1[0] + v1[1] * v1[1] + v1[2] * v1[2] + v1[3] * v1[3]; }
                ss += __shfl_xor(ss, 16); ss += __shfl_xor(ss, 32);
                if (fq == 0) atomicAdd(rowss3 + row, ss); }
    }
};

template <class Epi, class Sched, bool ALIGN_EPI = false, bool SP2 = false>
__device__ __forceinline__ void gemm_phase(LAS unsigned char* lds, const Gemm g, const Sched& S, const Epi& E) {
    const int tid = threadIdx.x, wid = __builtin_amdgcn_readfirstlane(tid >> 6), lane = tid & 63, wr = wid >> 2, wc = wid & 3, fr = lane & 15, fq = lane >> 4;
    const int K = g.K, nt = K / BK;
    unsigned voffA[2], voffB[2];
#pragma unroll
    for (int i = 0; i < 2; ++i) { int R, C; stage_rc(tid * 16 + i * 8192, R, C); const int Rb = Epi::PERM ? ((R & ~31) + perm32(R & 31)) : R;
        voffA[i] = (unsigned)(R * K + C) * 2u; voffB[i] = (unsigned)(Rb * K + C) * 2u; }
    const size_t kstep = (size_t)(BK * 2);
    const size_t hstep = (size_t)HALF * K * 2;
    const size_t tstep = 2 * hstep;
    const unsigned ldsw = (unsigned)wid * 1024u;
    const int aoff = lds_byte(wr * 64 + fr, fq * 8), boff = lds_byte(wc * 32 + fr, fq * 8);
#define PG8_SA(b, h) (((b) * 2 + (h)) * HTB)
#define PG8_SB(b, h) ((4 + (b) * 2 + (h)) * HTB)
#define PG8_STAGE(bufoff, gbase, voff) do { _Pragma("unroll") for (int _i = 0; _i < 2; ++_i) \
        __builtin_amdgcn_global_load_lds((const unsigned*)((const char*)(gbase) + (voff)[_i]), (LAS unsigned*)(lds + (bufoff) + ldsw + _i * 8192), 16, 0, 0); } while (0)
#define PG8_LDA(dst, b, h) do { _Pragma("unroll") for (int m = 0; m < 4; ++m) _Pragma("unroll") for (int k = 0; k < 2; ++k) dst[m][k] = *(const LAS bf16x8*)(lds + PG8_SA(b, h) + aoff + m * 2048 + k * 1024); } while (0)
#define PG8_LDB(dst, b, h) do { _Pragma("unroll") for (int n = 0; n < 2; ++n) _Pragma("unroll") for (int k = 0; k < 2; ++k) dst[n][k] = *(const LAS bf16x8*)(lds + PG8_SB(b, h) + boff + n * 2048 + k * 1024); } while (0)
#define PG8_MMA(ai, bj, At, Bt) do { __builtin_amdgcn_s_setprio(1); _Pragma("unroll") for (int m = 0; m < 4; ++m) _Pragma("unroll") for (int n = 0; n < 2; ++n) _Pragma("unroll") for (int k = 0; k < 2; ++k) \
        acc[ai][bj][m][n] = __builtin_amdgcn_mfma_f32_16x16x32_bf16(Bt[n][k], At[m][k], acc[ai][bj][m][n], 0, 0, 0); __builtin_amdgcn_s_setprio(0); } while (0)
#define PG8_WAIT_V(n) asm volatile("s_waitcnt vmcnt(" #n ")" ::: "memory")
#define PG8_WAIT_L(n) asm volatile("s_waitcnt lgkmcnt(" #n ")" ::: "memory")
#define PG8_BAR __builtin_amdgcn_s_barrier()
#define PG8_SCHED __builtin_amdgcn_sched_barrier(0)
    Unit cur, nxt; int ui = 0;
    if (!S.next(0, cur)) return;
    f32x4 acc[2][2][4][2];
#pragma unroll
    for (int a = 0; a < 2; ++a)
#pragma unroll
        for (int b = 0; b < 2; ++b)
#pragma unroll
            for (int m = 0; m < 4; ++m)
#pragma unroll
                for (int n = 0; n < 2; ++n) acc[a][b][m][n] = (f32x4){0.f, 0.f, 0.f, 0.f};
    bf16x8 At[4][2], B0[2][2], B1[2][2];
    const char* cA = (const char*)g.A + (size_t)cur.pm * tstep; const char* cB = (const char*)g.Bt + (size_t)cur.pn * tstep;
    S.a_ready(cur);
    if constexpr (SP2) {
        PG8_STAGE(PG8_SB(0, 0), cB, voffB); PG8_STAGE(PG8_SB(0, 1), cB + hstep, voffB); PG8_STAGE(PG8_SA(0, 0), cA, voffA); PG8_STAGE(PG8_SA(0, 1), cA + hstep, voffA);
        if (wr == 1) PG8_BAR;
        PG8_WAIT_V(2); PG8_BAR;
        PG8_STAGE(PG8_SB(1, 0), cB + kstep, voffB); PG8_STAGE(PG8_SA(1, 0), cA + kstep, voffA); PG8_STAGE(PG8_SB(1, 1), cB + hstep + kstep, voffB);
        PG8_WAIT_V(6); PG8_BAR;
    } else {
        PG8_STAGE(PG8_SB(0, 0), cB, voffB); PG8_STAGE(PG8_SA(0, 0), cA, voffA); PG8_STAGE(PG8_SB(0, 1), cB + hstep, voffB); PG8_STAGE(PG8_SA(0, 1), cA + hstep, voffA);
        if (wr == 1) PG8_BAR;
        PG8_WAIT_V(4); PG8_BAR;
        PG8_STAGE(PG8_SB(1, 0), cB + kstep, voffB); PG8_STAGE(PG8_SA(1, 0), cA + kstep, voffA); PG8_STAGE(PG8_SB(1, 1), cB + hstep + kstep, voffB);
        PG8_WAIT_V(6); PG8_BAR;
    }
    for (;;) {
        const bool has_next = S.next(ui + 1, nxt);
        const char* nA = has_next ? (const char*)g.A + (size_t)nxt.pm * tstep : cA; const char* nB = has_next ? (const char*)g.Bt + (size_t)nxt.pn * tstep : cB;
        for (int t = 0; t < nt; t += 2) {
            const bool last = (t == nt - 2);
            const char* a1 = cA + (size_t)(t + 1) * kstep;
            const char* a2 = last ? nA : cA + (size_t)(t + 2) * kstep; const char* b2 = last ? nB : cB + (size_t)(t + 2) * kstep;
            const char* a3 = a2 + kstep; const char* b3 = b2 + kstep;
            if (last && has_next) S.a_ready(nxt);
            if constexpr (SP2) {
            PG8_LDB(B0, 0, 0); PG8_LDB(B1, 0, 1); PG8_SCHED; PG8_LDA(At, 0, 0); PG8_STAGE(PG8_SA(1, 1), a1 + hstep, voffA);
            PG8_WAIT_V(8); PG8_WAIT_L(0); PG8_BAR; PG8_MMA(0, 0, At, B0); PG8_MMA(0, 1, At, B1); PG8_BAR; PG8_SCHED;
            PG8_LDA(At, 0, 1); PG8_STAGE(PG8_SB(0, 0), b2, voffB); PG8_STAGE(PG8_SB(0, 1), b2 + hstep, voffB); PG8_STAGE(PG8_SA(0, 0), a2, voffA);
            PG8_WAIT_V(8); PG8_WAIT_L(0); PG8_BAR; PG8_MMA(1, 0, At, B0); PG8_MMA(1, 1, At, B1); PG8_BAR; PG8_SCHED;
            PG8_LDB(B0, 1, 0); PG8_LDB(B1, 1, 1); PG8_SCHED; PG8_LDA(At, 1, 0); PG8_STAGE(PG8_SA(0, 1), a2 + hstep, voffA);
            PG8_WAIT_V(8); PG8_WAIT_L(0); PG8_BAR; PG8_MMA(0, 0, At, B0); PG8_MMA(0, 1, At, B1); PG8_BAR; PG8_SCHED;
            PG8_LDA(At, 1, 1); PG8_STAGE(PG8_SB(1, 0), b3, voffB); PG8_STAGE(PG8_SB(1, 1), b3 + hstep, voffB); PG8_STAGE(PG8_SA(1, 0), a3, voffA);
            PG8_WAIT_V(8); PG8_WAIT_L(0); PG8_BAR; PG8_MMA(1, 0, At, B0); PG8_MMA(1, 1, At, B1); PG8_BAR; PG8_SCHED;
            } else {
            PG8_LDB(B0, 0, 0); PG8_SCHED; PG8_LDA(At, 0, 0); PG8_STAGE(PG8_SA(1, 1), a1 + hstep, voffA);
            PG8_WAIT_L(8); PG8_BAR; PG8_WAIT_L(0); PG8_MMA(0, 0, At, B0); PG8_BAR; PG8_SCHED;
            PG8_LDB(B1, 0, 1); PG8_STAGE(PG8_SB(0, 0), b2, voffB);
            PG8_BAR; PG8_WAIT_L(0); PG8_MMA(0, 1, At, B1); PG8_BAR;
            PG8_LDA(At, 0, 1); PG8_STAGE(PG8_SA(0, 0), a2, voffA);
            PG8_BAR; PG8_WAIT_L(0); PG8_MMA(1, 0, At, B0); PG8_BAR; PG8_SCHED;
            PG8_STAGE(PG8_SB(0, 1), b2 + hstep, voffB);
            PG8_WAIT_V(6); PG8_BAR; PG8_MMA(1, 1, At, B1); PG8_BAR;
            PG8_LDB(B0, 1, 0); PG8_SCHED; PG8_LDA(At, 1, 0); PG8_STAGE(PG8_SA(0, 1), a2 + hstep, voffA);
            PG8_WAIT_L(8); PG8_BAR; PG8_WAIT_L(0); PG8_MMA(0, 0, At, B0); PG8_BAR; PG8_SCHED;
            PG8_LDB(B1, 1, 1); PG8_STAGE(PG8_SB(1, 0), b3, voffB);
            PG8_BAR; PG8_WAIT_L(0); PG8_MMA(0, 1, At, B1); PG8_BAR;
            PG8_LDA(At, 1, 1); PG8_STAGE(PG8_SA(1, 0), a3, voffA);
            PG8_BAR; PG8_WAIT_L(0); PG8_MMA(1, 0, At, B0); PG8_BAR; PG8_SCHED;
            PG8_STAGE(PG8_SB(1, 1), b3 + hstep, voffB);
            PG8_WAIT_V(6); PG8_BAR; PG8_MMA(1, 1, At, B1); PG8_BAR;
            }
        }
        if constexpr (ALIGN_EPI) { if (wr == 0) PG8_BAR; }
        if constexpr (!Epi::AFTER_DRAIN) { E(acc, cur, wr, wc, fr, fq); S.done(cur); }
        if (!has_next) break;
#pragma unroll
        for (int a = 0; a < 2; ++a)
#pragma unroll
            for (int b = 0; b < 2; ++b)
#pragma unroll
                for (int m = 0; m < 4; ++m)
#pragma unroll
                    for (int n = 0; n < 2; ++n) acc[a][b][m][n] = (f32x4){0.f, 0.f, 0.f, 0.f};
        cur = nxt; cA = nA; cB = nB; ++ui;
        if constexpr (ALIGN_EPI) { if (wr == 1) PG8_BAR; }
    }
    PG8_WAIT_V(0);
    if constexpr (!ALIGN_EPI) { if (wr == 0) PG8_BAR; }
    PG8_BAR;
    if constexpr (Epi::AFTER_DRAIN) { E.fused(acc, cur, wr, wc, fr, fq, lds, wid, lane); S.done(cur); }
#undef PG8_SA
#undef PG8_SB
#undef PG8_STAGE
#undef PG8_LDA
#undef PG8_LDB
#undef PG8_MMA
#undef PG8_WAIT_V
#undef PG8_WAIT_L
#undef PG8_BAR
#undef PG8_SCHED
}
}

struct Args {
    const float *x_prompt, *x_sample, *st_wkv, *st_shift, *cache_k, *cache_v, *p_prompt, *p_sample, *g_norm, *w_in, *mu, *w0, *w2, *a0, *a2,
                *k_k, *k_a, *r_k, *ln_w, *ln_b, *sinks, *w_out, *g_ple, *w_pg, *w_pp, *g_final;
    float* out; unsigned char* ws;
};

__device__ __forceinline__ void p0_transpose_item(const float* W, int K, int N, bf16_t* WT, const float* kscale, LAS float* scr, int item, int lane) {
    const int nblk = N / 32, kb = item / nblk, nb = item % nblk, k0 = 64 * kb, n0 = 32 * nb;
    float wv[32];
#pragma unroll
    for (int i = 0; i < 32; ++i) { const int kk = 2 * i + (lane >> 5); wv[i] = W[(size_t)(k0 + kk) * N + n0 + (lane & 31)]; }
#pragma unroll
    for (int i = 0; i < 32; ++i) { const int kk = 2 * i + (lane >> 5); float v = wv[i]; if (kscale) v *= kscale[k0 + kk]; scr[kk * 33 + (lane & 31)] = v; }
    LDS_WAIT();
    const int c = lane & 7;
#pragma unroll
    for (int j = 0; j < 4; ++j) { const int n = (lane >> 3) + 8 * j; const LAS float* s = scr + (8 * c) * 33 + n;
        u32x4 o; o.x = pk2(s[0 * 33], s[1 * 33]); o.y = pk2(s[2 * 33], s[3 * 33]); o.z = pk2(s[4 * 33], s[5 * 33]); o.w = pk2(s[6 * 33], s[7 * 33]);
        *(u32x4*)(WT + (size_t)(n0 + n) * K + k0 + 8 * c) = o; }
    LDS_WAIT();
}

__device__ __forceinline__ void p0_prologue(const Args& A, LAS unsigned char* lds, int tid, int lane, int wave) {
    unsigned char* ws = A.ws;
    LAS float* scr = (LAS float*)(lds + wave * 16384);
    const int gw = blockIdx.x * 8 + wave, NGW = gridDim.x * 8;
    bf16_t* Win_t = (bf16_t*)(ws + WS_WIN); bf16_t* Wout_t = (bf16_t*)(ws + WS_WOUT); bf16_t* Wpg_t = (bf16_t*)(ws + WS_WPG); bf16_t* Wpp_t = (bf16_t*)(ws + WS_WPP);
    constexpr int I_IN = 16 * (IN_DIM / 32), I_O = 16 * 32, I_PG = 16 * 32, I_PP = 4 * 32, NITEMS = I_IN + I_O + I_PG + I_PP;
    for (int it = gw; it < NITEMS; it += NGW) {
        int r = it;
        if (r < I_IN) { p0_transpose_item(A.w_in, DM, IN_DIM, Win_t, nullptr, scr, r, lane); continue; } r -= I_IN;
        if (r < I_O) { p0_transpose_item(A.w_out, DM, DM, Wout_t, nullptr, scr, r, lane); continue; } r -= I_O;
        if (r < I_PG) { p0_transpose_item(A.w_pg, DM, DM, Wpg_t, A.g_ple, scr, r, lane); continue; } r -= I_PG;
        p0_transpose_item(A.w_pp, PLE, DM, Wpp_t, nullptr, scr, r, lane);
    }
    { unsigned* ctl = (unsigned*)(ws + WS_CTL); const int gt = blockIdx.x * 512 + tid, NT = gridDim.x * 512;
      for (int i = gt; i < CW_SS3 + MTOT; i += NT) ctl[i] = 0u; }
    { const int gt = blockIdx.x * 512 + tid, NT = gridDim.x * 512; u32x4* zp = (u32x4*)(Win_t + (size_t)IN_DIM * DM);
      for (int i = gt; i < (NZ - IN_DIM) * DM / 8; i += NT) zp[i] = (u32x4){0u, 0u, 0u, 0u}; }
    { const int gt = blockIdx.x * 512 + tid, NT = gridDim.x * 512; float* ct = (float*)(ws + WS_ROPE); float* st = ct + 2056 * 8;
      for (int i = gt; i < 2056 * 8; i += NT) { const int pi = i >> 3, fi = i & 7; const int pos = pi < 2048 ? pi : 16384 + pi - 2048;
          const float inv = fi == 0 ? 1.0f : fi == 1 ? 0.19392274f : fi == 2 ? 0.03760603f : fi == 3 ? 0.0072926646f : fi == 4 ? 0.0014142136f : fi == 5 ? 0.0002742482f : fi == 6 ? 5.3182957e-05f : 1.0313385e-05f;
          const float angf = (float)pos * inv; const double ang = (double)angf; const double n = __builtin_rint(ang * 0.15915494309189535); const double r = __builtin_fma(-n, 6.283185307179586, ang);
          const float rf = (float)r; ct[i] = cosf(rf); st[i] = sinf(rf); } }
    { const int gt = blockIdx.x * 512 + tid, NT = gridDim.x * 512; bf16_t* W2T = (bf16_t*)(ws + WS_W2T); bf16_t* A2T = (bf16_t*)(ws + WS_A2T);
      for (int i = gt; i < 512 * 64; i += NT) { const int cc = i >> 6, j = i & 63; W2T[i] = (bf16_t)f2bf(A.w2[j * 512 + cc]); A2T[i] = (bf16_t)f2bf(A.a2[j * 512 + cc]); } }
    bf16_t* XN = (bf16_t*)(ws + WS_XN); bf16_t* PB = (bf16_t*)(ws + WS_PB);
    f32x4 gv[4];
#pragma unroll
    for (int j = 0; j < 4; ++j) gv[j] = *((const f32x4*)A.g_norm + lane + 64 * j);
    {
        f32x4 v[4], nv[4]; f32x4 pv, npv;
        int m = gw;
        if (m < MTOT) { const float* xrow = m < MP ? A.x_prompt + (size_t)m * DM : A.x_sample + (size_t)(m - MP) * DM; const float* prow = m < MP ? A.p_prompt + (size_t)m * PLE : A.p_sample + (size_t)(m - MP) * PLE;
#pragma unroll
            for (int j = 0; j < 4; ++j) v[j] = *((const f32x4*)xrow + lane + 64 * j);
            pv = *((const f32x4*)prow + lane); }
        for (; m < MTOT; m += NGW) {
            const int mn = m + NGW;
            if (mn < MTOT) { const float* xrow = mn < MP ? A.x_prompt + (size_t)mn * DM : A.x_sample + (size_t)(mn - MP) * DM; const float* prow = mn < MP ? A.p_prompt + (size_t)mn * PLE : A.p_sample + (size_t)(mn - MP) * PLE;
#pragma unroll
                for (int j = 0; j < 4; ++j) nv[j] = *((const f32x4*)xrow + lane + 64 * j);
                npv = *((const f32x4*)prow + lane); }
            float s = 0.f;
#pragma unroll
            for (int j = 0; j < 4; ++j) s += (v[j].x * v[j].x + v[j].y * v[j].y) + (v[j].z * v[j].z + v[j].w * v[j].w);
            const float rstd = __builtin_amdgcn_rsqf(wave_sum(s) * (1.f / DM) + NORM_EPS);
            u32x2* o8 = (u32x2*)(XN + (size_t)m * DM) + lane;
#pragma unroll
            for (int j = 0; j < 4; ++j) { u32x2 o; o.x = pk2(v[j].x * rstd * gv[j].x, v[j].y * rstd * gv[j].y); o.y = pk2(v[j].z * rstd * gv[j].z, v[j].w * rstd * gv[j].w); o8[64 * j] = o; }
            u32x2 po; po.x = pk2(pv.x, pv.y); po.y = pk2(pv.z, pv.w);
            *((u32x2*)(PB + (size_t)m * PLE) + lane) = po;
#pragma unroll
            for (int j = 0; j < 4; ++j) v[j] = nv[j];
            pv = npv;
        }
    }
}

constexpr int SC_ZS = 0, SC_OP = 40960, SC_Y = 81920, SC_C = 90112;
__device__ __forceinline__ void sscan_item(const Args& A, LAS unsigned char* lds, int tid, int lane, int wave, int bg, int h) {
    const bf16_t* Z = (const bf16_t*)(A.ws + WS_Z); bf16_t* MIX = (bf16_t*)(A.ws + WS_XN);
    LAS float* ZS = (LAS float*)(lds + SC_ZS); LAS float* OP = (LAS float*)(lds + SC_OP); LAS float* YB = (LAS float*)(lds + SC_Y); LAS float* CB = (LAS float*)(lds + SC_C);
    const int fr = lane & 15, q4 = lane >> 4;
    const int mt = wave & 1, nt = wave >> 1, cl = nt * 16 + fr, cg_ = h * 64 + cl;
    bf16x8 bw[2], ba[2];
#pragma unroll
    for (int ks = 0; ks < 2; ++ks) { bw[ks] = *(const bf16x8*)((const bf16_t*)(A.ws + WS_W2T) + cg_ * 64 + ks * 32 + q4 * 8); ba[ks] = *(const bf16x8*)((const bf16_t*)(A.ws + WS_A2T) + cg_ * 64 + ks * 32 + q4 * 8); }
    const float w0c = A.w0[cg_], a0c = A.a0[cg_], kkc = A.k_k[cg_], kac = A.k_a[cg_];
    const float rkl = A.r_k[h * 64 + lane], lnw = A.ln_w[h * 64 + lane], lnb = A.ln_b[h * 64 + lane];
    const int vr = (tid >> 3) & 31, kq = tid & 7;
    f32x4 s0pre[2][4];
#pragma unroll
    for (int rep = 0; rep < 2; ++rep) { const int b_ = bg * 4 + (tid >> 8) + 2 * rep; const float* S0_ = A.st_wkv + ((size_t)b_ * 8 + h) * 4096;
        s0pre[rep][0] = *(const f32x4*)(S0_ + vr * 64 + kq * 8); s0pre[rep][1] = *(const f32x4*)(S0_ + vr * 64 + kq * 8 + 4);
        s0pre[rep][2] = *(const f32x4*)(S0_ + (vr + 32) * 64 + kq * 8); s0pre[rep][3] = *(const f32x4*)(S0_ + (vr + 32) * 64 + kq * 8 + 4); }
    {
        for (int idx = tid; idx < 32 * 40; idx += 512) {
            const int t = idx / 40, cc = idx % 40, s = cc >> 3, within = (cc & 7) * 8;
            float o[8];
            {
                const int bi = t >> 3, tt = t & 7, b = bg * 4 + bi; const float* shift0 = A.st_shift + (size_t)b * SHIFT;
                const int zcol = (s == 0 ? h * 64 : s == 1 ? 512 + h * 64 : s == 2 ? 1024 + h * 64 : s == 3 ? 1536 : 1600) + within;
                const size_t row = (size_t)MP + (size_t)b * 8 + tt;
                float cur[8], prv[8]; unpack8(*(const u32x4*)(Z + row * NZ + zcol), cur);
                if (tt == 0) {
                    { const f32x4 p0 = *(const f32x4*)(shift0 + zcol), p1 = *(const f32x4*)(shift0 + zcol + 4);
                        prv[0] = p0.x; prv[1] = p0.y; prv[2] = p0.z; prv[3] = p0.w; prv[4] = p1.x; prv[5] = p1.y; prv[6] = p1.z; prv[7] = p1.w; }
                } else unpack8(*(const u32x4*)(Z + (row - 1) * NZ + zcol), prv);
                const f32x4 m0 = *(const f32x4*)(A.mu + zcol), m1 = *(const f32x4*)(A.mu + zcol + 4);
                const float mu[8] = {m0.x, m0.y, m0.z, m0.w, m1.x, m1.y, m1.z, m1.w};
#pragma unroll
                for (int i = 0; i < 8; ++i) { float v = cur[i] + mu[i] * (prv[i] - cur[i]); if (s == 3) v = tanhf(v); o[i] = v; }
            }
            LAS f32x4* dst = (LAS f32x4*)(ZS + t * 320 + s * 64 + within);
            dst[0] = (f32x4){o[0], o[1], o[2], o[3]}; dst[1] = (f32x4){o[4], o[5], o[6], o[7]};
        }
        __syncthreads();
        {
            f32x4 accw = {0.f, 0.f, 0.f, 0.f}, acca = {0.f, 0.f, 0.f, 0.f};
#pragma unroll
            for (int ks = 0; ks < 2; ++ks) {
                const LAS f32x4* pt = (const LAS f32x4*)(ZS + (mt * 16 + fr) * 320 + 192 + ks * 32 + q4 * 8);
                const LAS f32x4* pa = (const LAS f32x4*)(ZS + (mt * 16 + fr) * 320 + 256 + ks * 32 + q4 * 8);
                const f32x4 t0v = pt[0], t1v = pt[1], a0v = pa[0], a1v = pa[1];
                u32x4 tw; tw.x = pk2(t0v.x, t0v.y); tw.y = pk2(t0v.z, t0v.w); tw.z = pk2(t1v.x, t1v.y); tw.w = pk2(t1v.z, t1v.w);
                u32x4 aw; aw.x = pk2(a0v.x, a0v.y); aw.y = pk2(a0v.z, a0v.w); aw.z = pk2(a1v.x, a1v.y); aw.w = pk2(a1v.z, a1v.w);
                accw = __builtin_amdgcn_mfma_f32_16x16x32_bf16(__builtin_bit_cast(bf16x8, tw), bw[ks], accw, 0, 0, 0);
                acca = __builtin_amdgcn_mfma_f32_16x16x32_bf16(__builtin_bit_cast(bf16x8, aw), ba[ks], acca, 0, 0, 0);
            }
#pragma unroll
            for (int j = 0; j < 4; ++j) {
                const int t = mt * 16 + q4 * 4 + j;
                const float xw = w0c + accw[j];
                const float dec = __expf(-0.6065306597126334f * sigmoidf_(xw));
                const float av = sigmoidf_(a0c + acca[j]);
                const float kx = ZS[t * 320 + 64 + cl], rr = ZS[t * 320 + cl];
                OP[t * 320 + cl] = kx * kkc; OP[t * 320 + 64 + cl] = rr * dec; OP[t * 320 + 128 + cl] = dec; OP[t * 320 + 192 + cl] = av;
                OP[t * 320 + 256 + cl] = kx * (1.f + (av - 1.f) * kac);
            }
        }
        __syncthreads();
#pragma unroll
        for (int i = 0; i < 4; ++i) {
            const int t = wave * 4 + i;
            const float kr = OP[t * 320 + lane], av = OP[t * 320 + 192 + lane], kv = OP[t * 320 + 256 + lane], rr = ZS[t * 320 + lane];
            const float n2 = wave_sum(kr * kr); const float inv = 1.f / fmaxf(sqrtf(n2), 1e-12f);
            const float kk = kr * inv, bb = kk * av;
            const float c1 = wave_sum(bb * rr), c2 = wave_sum(kv * rr), bc = wave_sum(rr * kv * rkl);
            OP[t * 320 + lane] = kk; OP[t * 320 + 192 + lane] = bb;
            if (lane == 0) { CB[t * 4 + 0] = c1; CB[t * 4 + 1] = c2; CB[t * 4 + 2] = bc; }
        }
        __syncthreads();
        {
            const int hh = tid >> 8;
#pragma unroll
            for (int rep = 0; rep < 2; ++rep) {
                const int bi = hh + 2 * rep, b = bg * 4 + bi;
                float* wkv_out = A.out + OUT_WKVS + ((size_t)b * 8 + h) * 4096;
                float s0[8], s1[8];
#pragma unroll
                for (int i = 0; i < 4; ++i) { s0[i] = s0pre[rep][0][i]; s0[4 + i] = s0pre[rep][1][i]; s1[i] = s0pre[rep][2][i]; s1[4 + i] = s0pre[rep][3][i]; }
                for (int tt = 0; tt < 8; ++tt) {
                    const int t = bi * 8 + tt;
                    const LAS f32x4* op = (const LAS f32x4*)(OP + t * 320 + kq * 8);
                    float kk[8], rw[8], ww[8], bb[8], kv[8];
                    { f32x4 a = op[0], c = op[1]; kk[0] = a.x; kk[1] = a.y; kk[2] = a.z; kk[3] = a.w; kk[4] = c.x; kk[5] = c.y; kk[6] = c.z; kk[7] = c.w; }
                    { f32x4 a = op[16], c = op[17]; rw[0] = a.x; rw[1] = a.y; rw[2] = a.z; rw[3] = a.w; rw[4] = c.x; rw[5] = c.y; rw[6] = c.z; rw[7] = c.w; }
                    { f32x4 a = op[32], c = op[33]; ww[0] = a.x; ww[1] = a.y; ww[2] = a.z; ww[3] = a.w; ww[4] = c.x; ww[5] = c.y; ww[6] = c.z; ww[7] = c.w; }
                    { f32x4 a = op[48], c = op[49]; bb[0] = a.x; bb[1] = a.y; bb[2] = a.z; bb[3] = a.w; bb[4] = c.x; bb[5] = c.y; bb[6] = c.z; bb[7] = c.w; }
                    { f32x4 a = op[64], c = op[65]; kv[0] = a.x; kv[1] = a.y; kv[2] = a.z; kv[3] = a.w; kv[4] = c.x; kv[5] = c.y; kv[6] = c.z; kv[7] = c.w; }
                    const float v0 = ZS[t * 320 + 128 + vr], v1 = ZS[t * 320 + 128 + vr + 32];
                    const float c1 = CB[t * 4 + 0], c2 = CB[t * 4 + 1];
                    float sa0 = 0.f, sa1 = 0.f, yp0 = 0.f, yp1 = 0.f;
#pragma unroll
                    for (int i = 0; i < 8; ++i) { sa0 += s0[i] * kk[i]; sa1 += s1[i] * kk[i]; yp0 += s0[i] * rw[i]; yp1 += s1[i] * rw[i]; }
                    sa0 = red8_sum(sa0); sa1 = red8_sum(sa1); yp0 = red8_sum(yp0); yp1 = red8_sum(yp1);
#pragma unroll
                    for (int i = 0; i < 8; ++i) { s0[i] = s0[i] * ww[i] - sa0 * bb[i] + v0 * kv[i]; s1[i] = s1[i] * ww[i] - sa1 * bb[i] + v1 * kv[i]; }
                    if (kq == 0) { YB[t * 64 + vr] = yp0 - sa0 * c1 + v0 * c2; YB[t * 64 + vr + 32] = yp1 - sa1 * c1 + v1 * c2; }
                }
                float* w0p = wkv_out + vr * 64 + kq * 8; float* w1p = wkv_out + (vr + 32) * 64 + kq * 8;
                *(f32x4*)w0p = (f32x4){s0[0], s0[1], s0[2], s0[3]}; *(f32x4*)(w0p + 4) = (f32x4){s0[4], s0[5], s0[6], s0[7]};
                *(f32x4*)w1p = (f32x4){s1[0], s1[1], s1[2], s1[3]}; *(f32x4*)(w1p + 4) = (f32x4){s1[4], s1[5], s1[6], s1[7]};
            }
        }
        __syncthreads();
#pragma unroll
        for (int i = 0; i < 4; ++i) {
            const int t = wave * 4 + i;
            {
                const float y = YB[t * 64 + lane];
                const float mean = wave_sum(y) * (1.f / 64.f); const float d = y - mean; const float var = wave_sum(d * d) * (1.f / 64.f);
                const float yn = d * (__builtin_amdgcn_rsqf(var + GN_EPS)) * lnw + lnb;
                const float o = yn + CB[t * 4 + 2] * ZS[t * 320 + 128 + lane];
                const size_t row = (size_t)MP + (size_t)(bg * 4 + (t >> 3)) * 8 + (t & 7);
                const float g = bf2f(Z[row * NZ + O_GR + h * 64 + lane]);
                MIX[row * DM + h * 64 + lane] = (bf16_t)f2bf(o * siluf_(g));
            }
        }
        __syncthreads();
    }
    if (h == 0) { for (int c = tid; c < 4 * SHIFT; c += 512) { const int bi = c / SHIFT, cc = c % SHIFT, b = bg * 4 + bi; const size_t row = (size_t)MP + (size_t)b * 8 + 7;
        A.out[OUT_SHS + (size_t)b * SHIFT + cc] = bf2f(Z[row * NZ + cc]); } }
}
constexpr int CA_ZR = 0, CA_ZK = 16384, CA_ZV = 32768, CA_TH = 49152, CA_AD = 58368, CA_LW = 67584, CA_AA = 83968, CA_SEG = 100352, CA_G = 102400;
constexpr int CA_KKT = 0, CA_BT = 9216, CA_KT = 18432, CA_RT = 27648, CA_NBHT = 36864, CA_KHT = 46080, CA_VT = 55296, CA_RHS = 64512, CA_XT = 0,
              CA_N = 102656, CA_MAK = 119040, CA_NMRB = 128256, CA_MRK = 137472;

__device__ __forceinline__ float wsum_fast(float x) {
    x += dppf<0xB1>(x); x += dppf<0x4E>(x); x += dppf<0x141>(x); x += dppf<0x140>(x);
    const int xi = __builtin_bit_cast(int, x);
    return __builtin_bit_cast(float, __builtin_amdgcn_readlane(xi, 0)) + __builtin_bit_cast(float, __builtin_amdgcn_readlane(xi, 16)) +
           __builtin_bit_cast(float, __builtin_amdgcn_readlane(xi, 32)) + __builtin_bit_cast(float, __builtin_amdgcn_readlane(xi, 48));
}
__device__ __forceinline__ bf16x8 ldsfrag(const LAS unsigned char* base, int row, int kofs) { return *(const LAS bf16x8*)(base + row * 144 + kofs * 2); }
__device__ __forceinline__ u32x2 pack4(float a, float b, float c, float d) { u32x2 o; o.x = pk2(a, b); o.y = pk2(c, d); return o; }
#define MFMA16(a, b, c) __builtin_amdgcn_mfma_f32_16x16x32_bf16(a, b, c, 0, 0, 0)


struct HeadConstA { int h; bf16x8 bw[2][2], ba[2][2]; float w0c[2], a0c[2], kkc, kac, rkc; };
__device__ __forceinline__ void load_headconst(const Args& A, HeadConstA& H, int h, int tid, int lane, int wave) {
    const int fr = lane & 15, q4 = lane >> 4, nth = wave >> 2;
    const bf16_t* W2T = (const bf16_t*)(A.ws + WS_W2T); const bf16_t* A2T = (const bf16_t*)(A.ws + WS_A2T);
#pragma unroll
    for (int nn = 0; nn < 2; ++nn) { const int cgl = h * 64 + (nth * 2 + nn) * 16 + fr;
#pragma unroll
        for (int ks = 0; ks < 2; ++ks) { H.bw[nn][ks] = *(const bf16x8*)(W2T + cgl * 64 + ks * 32 + q4 * 8); H.ba[nn][ks] = *(const bf16x8*)(A2T + cgl * 64 + ks * 32 + q4 * 8); }
        H.w0c[nn] = A.w0[cgl]; H.a0c[nn] = A.a0[cgl]; }
    { const int cgl = h * 64 + lane; H.kkc = A.k_k[cgl]; H.kac = A.k_a[cgl]; H.rkc = A.r_k[cgl]; }
    H.h = h;
}

__device__ __forceinline__ void chunkA_item(const Args& A, LAS unsigned char* lds, int tid, int lane, int wave, int ci, int ci_next, HeadConstA& H) {
    const int c = ci & 31, h = (ci >> 5) & 7, b = ci >> 8;
    if (h != H.h) load_headconst(A, H, h, tid, lane, wave);
    const bf16_t* Z = (const bf16_t*)(A.ws + WS_Z);
    const size_t row0 = (size_t)b * SEQ + c * 64;
    const int fr = lane & 15, q4 = lane >> 4;
    {
        const int t = tid >> 3, part = tid & 7; const bool first = (c == 0 && t == 0);
        const bf16_t* zr = Z + (row0 + t) * NZ; const bf16_t* zp = zr - NZ;
#pragma unroll
        for (int s = 0; s < 5; ++s) {
            const int zcol = (s == 0 ? h * 64 : s == 1 ? 512 + h * 64 : s == 2 ? 1024 + h * 64 : s == 3 ? 1536 : 1600) + part * 8;
            const u32x4 cu = *(const u32x4*)(zr + zcol); u32x4 pu = {0u, 0u, 0u, 0u}; if (!first) pu = *(const u32x4*)(zp + zcol);
            const f32x4 m0 = *(const f32x4*)(A.mu + zcol), m1 = *(const f32x4*)(A.mu + zcol + 4);
            float cur[8], prv[8], o[8]; unpack8(cu, cur); unpack8(pu, prv);
            const float mu[8] = {m0.x, m0.y, m0.z, m0.w, m1.x, m1.y, m1.z, m1.w};
#pragma unroll
            for (int i = 0; i < 8; ++i) o[i] = cur[i] + mu[i] * (prv[i] - cur[i]);
            if (s < 3) { LAS f32x4* dst = (LAS f32x4*)(lds + s * 16384 + (t * 64 + part * 8) * 4); dst[0] = (f32x4){o[0], o[1], o[2], o[3]}; dst[1] = (f32x4){o[4], o[5], o[6], o[7]}; }
            else { if (s == 3) {
#pragma unroll
                    for (int i = 0; i < 8; ++i) o[i] = 1.f - 2.f * __builtin_amdgcn_rcpf(1.f + __expf(2.f * o[i])); }
                *(LAS u32x4*)(lds + (s == 3 ? CA_TH : CA_AD) + t * 144 + part * 16) = pack8(o); }
        }
    }
    LBAR();
    {
        const int mt = wave & 3, nth = wave >> 2;
        bf16x8 ath[2], aad[2];
#pragma unroll
        for (int ks = 0; ks < 2; ++ks) { ath[ks] = ldsfrag(lds + CA_TH, mt * 16 + fr, ks * 32 + q4 * 8); aad[ks] = ldsfrag(lds + CA_AD, mt * 16 + fr, ks * 32 + q4 * 8); }
#pragma unroll
        for (int nn = 0; nn < 2; ++nn) {
            const int cl = (nth * 2 + nn) * 16 + fr;
            f32x4 accw = {0.f, 0.f, 0.f, 0.f}, acca = {0.f, 0.f, 0.f, 0.f};
#pragma unroll
            for (int ks = 0; ks < 2; ++ks) { accw = MFMA16(ath[ks], H.bw[nn][ks], accw); acca = MFMA16(aad[ks], H.ba[nn][ks], acca); }
            const float w0c = H.w0c[nn], a0c = H.a0c[nn];
#pragma unroll
            for (int jj = 0; jj < 4; ++jj) { const int t = mt * 16 + q4 * 4 + jj;
                ((LAS float*)(lds + CA_LW))[t * 64 + cl] = -0.6065306597126334f * sigmoidf_(w0c + accw[jj]);
                ((LAS float*)(lds + CA_AA))[t * 64 + cl] = sigmoidf_(a0c + acca[jj]); }
        }
    }
    LBAR();
    {
        const int cc = lane, seg = wave;
        float lwv[8], pre[8], zr[8], zk[8], zv[8], av[8];
#pragma unroll
        for (int i = 0; i < 8; ++i) { const int t = seg * 8 + i; lwv[i] = ((LAS float*)(lds + CA_LW))[t * 64 + cc]; zr[i] = ((LAS float*)(lds + CA_ZR))[t * 64 + cc];
            zk[i] = ((LAS float*)(lds + CA_ZK))[t * 64 + cc]; zv[i] = ((LAS float*)(lds + CA_ZV))[t * 64 + cc]; av[i] = ((LAS float*)(lds + CA_AA))[t * 64 + cc]; }
        pre[0] = lwv[0];
#pragma unroll
        for (int i = 1; i < 8; ++i) pre[i] = pre[i - 1] + lwv[i];
        ((LAS float*)(lds + CA_SEG))[seg * 64 + cc] = pre[7];
        LBAR();
        float off = 0.f, tot = 0.f;
#pragma unroll
        for (int s = 0; s < 8; ++s) { const float v = ((LAS float*)(lds + CA_SEG))[s * 64 + cc]; tot += v; if (s < seg) off += v; }
        const float kkc = H.kkc, kac = H.kac, rkc = H.rkc;
        float rhs8[8], nbh8[8], kh8[8];
        float* BCg = (float*)(A.ws + WS_BC) + (size_t)ci * 64;
#pragma unroll
        for (int i = 0; i < 8; ++i) { const int t = seg * 8 + i;
            const float lg = off + pre[i], lgp = lg - lwv[i];
            const float kkraw = zk[i] * kkc; const float n2 = wsum_fast(kkraw * kkraw); const float kk = kkraw * __builtin_amdgcn_rsqf(fmaxf(n2, 1e-24f));
            const float a = av[i], bb = kk * a, km = zk[i] * (1.f + (a - 1.f) * kac);
            const float bc = wsum_fast(zr[i] * km * rkc); if (lane == 0) BCg[t] = bc;
            const float e_in = __expf(lg), e_pr = __expf(lgp), e_out = __expf(-lg), e_h = __expf(tot - lg);
            const float kkt = kk * e_pr; rhs8[i] = kkt; nbh8[i] = -(bb * e_h); kh8[i] = km * e_h;
            *(LAS unsigned short*)(lds + CA_KKT + t * 144 + cc * 2) = (unsigned short)f2bf(kkt);
            *(LAS unsigned short*)(lds + CA_RT + t * 144 + cc * 2) = (unsigned short)f2bf(zr[i] * e_in);
            *(LAS unsigned short*)(lds + CA_BT + t * 144 + cc * 2) = (unsigned short)f2bf(bb * e_out);
            *(LAS unsigned short*)(lds + CA_KT + t * 144 + cc * 2) = (unsigned short)f2bf(km * e_out); }
        *(LAS u32x4*)(lds + CA_NBHT + cc * 144 + seg * 16) = pack8(nbh8); *(LAS u32x4*)(lds + CA_KHT + cc * 144 + seg * 16) = pack8(kh8); *(LAS u32x4*)(lds + CA_VT + cc * 144 + seg * 16) = pack8(zv);
        LAS f32x4* rp = (LAS f32x4*)(lds + CA_RHS + (cc * 68 + seg * 8) * 4); rp[0] = (f32x4){rhs8[0], rhs8[1], rhs8[2], rhs8[3]}; rp[1] = (f32x4){rhs8[4], rhs8[5], rhs8[6], rhs8[7]};
        if (seg == 0) ((LAS float*)(lds + CA_G))[cc] = __expf(tot);
    }
    LBAR();
    {
        const int og = wave >> 2, ms = wave & 3;
        const LAS unsigned char* Bsrc = lds + (og == 0 ? CA_KKT : CA_RT);
        bf16x8 aB[2], aK[2];
#pragma unroll
        for (int ks = 0; ks < 2; ++ks) { aB[ks] = ldsfrag(lds + CA_BT, ms * 16 + fr, ks * 32 + q4 * 8); aK[ks] = ldsfrag(lds + CA_KT, ms * 16 + fr, ks * 32 + q4 * 8); }
        LAS unsigned char* O1 = lds + (og == 0 ? CA_MAK : CA_MRK);
#pragma unroll
        for (int nt = 0; nt < 4; ++nt) {
            const int t = nt * 16 + fr, s0 = ms * 16 + q4 * 4;
            if (nt < ms) {
                *(LAS u32x2*)(O1 + t * 144 + s0 * 2) = (u32x2){0u, 0u};
                if (og == 1) *(LAS u32x2*)(lds + CA_NMRB + t * 144 + s0 * 2) = (u32x2){0u, 0u};
            } else {
                f32x4 acc1 = {0.f, 0.f, 0.f, 0.f}, acc2 = {0.f, 0.f, 0.f, 0.f};
#pragma unroll
                for (int ks = 0; ks < 2; ++ks) { const bf16x8 bb = ldsfrag(Bsrc, t, ks * 32 + q4 * 8); acc1 = MFMA16(aB[ks], bb, acc1); acc2 = MFMA16(aK[ks], bb, acc2); }
                float v1[4], v2[4];
#pragma unroll
                for (int jj = 0; jj < 4; ++jj) { const int s = s0 + jj; const bool ok = og == 0 ? (s < t) : (s <= t); v1[jj] = ok ? acc1[jj] : 0.f; v2[jj] = ok ? acc2[jj] : 0.f; }
                *(LAS u32x2*)(O1 + t * 144 + s0 * 2) = pack4(v2[0], v2[1], v2[2], v2[3]);
                if (og == 0) {
#pragma unroll
                    for (int jj = 0; jj < 4; ++jj) ((LAS float*)(lds + CA_N))[t * 64 + jj * 16 + ms * 4 + q4] = v1[jj];
                } else *(LAS u32x2*)(lds + CA_NMRB + t * 144 + s0 * 2) = pack4(-v1[0], -v1[1], -v1[2], -v1[3]);
            }
        }
    }
    LBAR();
    {
        const int mt = wave >> 1;
        bf16x8 aM[2];
#pragma unroll
        for (int ks = 0; ks < 2; ++ks) aM[ks] = ldsfrag(lds + CA_MAK, mt * 16 + fr, ks * 32 + q4 * 8);
#pragma unroll
        for (int nn = 0; nn < 2; ++nn) { const int nt = (wave & 1) * 2 + nn; f32x4 acc = {0.f, 0.f, 0.f, 0.f};
#pragma unroll
            for (int ks = 0; ks < 2; ++ks) acc = MFMA16(aM[ks], ldsfrag(lds + CA_VT, nt * 16 + fr, ks * 32 + q4 * 8), acc);
            *(LAS f32x4*)(lds + CA_RHS + ((64 + nt * 16 + fr) * 68 + mt * 16 + q4 * 4) * 4) = acc; }
    }
    LBAR();
    if (tid < 256) {
        const int cp = tid >> 2, q = tid & 3;
        f32x2_t xa[8], xb[8];
#pragma unroll
        for (int m = 0; m < 8; ++m) { xa[m] = (f32x2_t){0.f, 0.f}; xb[m] = (f32x2_t){0.f, 0.f}; }
        const LAS float* Np = (const LAS float*)(lds + CA_N) + q * 16;
        const LAS float* Ra = (const LAS float*)(lds + CA_RHS) + cp * 68; const LAS float* Rb = Ra + 64 * 68;
        float a4[4], b4[4];
#pragma unroll
        for (int t = 0; t < 64; ++t) {
            f32x2_t sa = {0.f, 0.f}, sb = {0.f, 0.f};
#pragma unroll
            for (int p = 0; p < ((t + 3) / 4 + 1) / 2; ++p) { const f32x2_t nv = *(const LAS f32x2_t*)(Np + t * 64 + 2 * p); sa += nv * xa[p]; sb += nv * xb[p]; }
            float ua = sa.x + sa.y, ub = sb.x + sb.y;
            ua += dppf<0xB1>(ua); ub += dppf<0xB1>(ub); ua += dppf<0x4E>(ua); ub += dppf<0x4E>(ub);
            const float xta = Ra[t] - ua, xtb = Rb[t] - ub;
            if (q == (t & 3)) { if ((t >> 2) & 1) { xa[t >> 3].y = xta; xb[t >> 3].y = xtb; } else { xa[t >> 3].x = xta; xb[t >> 3].x = xtb; } }
            a4[t & 3] = xta; b4[t & 3] = xtb;
            if ((t & 3) == 3 && q == 0) { *(LAS u32x2*)(lds + CA_XT + cp * 144 + (t - 3) * 2) = pack4(a4[0], a4[1], a4[2], a4[3]);
                *(LAS u32x2*)(lds + CA_XT + (64 + cp) * 144 + (t - 3) * 2) = pack4(b4[0], b4[1], b4[2], b4[3]); }
        }
    } else if (ci_next < 4096) {
        const int cn = ci_next & 31, hn = (ci_next >> 5) & 7, bn = ci_next >> 8; const long rown = (long)bn * SEQ + cn * 64 - 1;
        for (int l = tid - 256; l < 65 * 5; l += 256) { const int r = l / 5, sec = l % 5; long rr = rown + r; if (rr < 0) rr = 0;
            const bf16_t* p = Z + rr * NZ + (sec == 0 ? hn * 64 : sec == 1 ? 512 + hn * 64 : sec == 2 ? 1024 + hn * 64 : sec == 3 ? 1536 : 1600);
            unsigned dummy; asm volatile("global_load_dword %0, %1, off" : "=v"(dummy) : "v"(p) : "memory"); }
        asm volatile("s_waitcnt vmcnt(0)" ::: "memory");
    }
    LBAR();
    {
        const int mt = wave >> 1;
        unsigned char* pq = (unsigned char*)A.out + CH_PQ + (size_t)ci * 24576; bf16_t* PTg = (bf16_t*)pq; float* Qg = (float*)(pq + 8192);
        bf16_t* RHg = (bf16_t*)(A.ws + WS_RY + (size_t)ci * 16384); bf16_t* Y0g = RHg + 4096;
        bf16x8 aX[2], aV[2], aS[2];
#pragma unroll
        for (int ks = 0; ks < 2; ++ks) { aX[ks] = ldsfrag(lds + CA_XT, mt * 16 + fr, ks * 32 + q4 * 8); aV[ks] = ldsfrag(lds + CA_VT, mt * 16 + fr, ks * 32 + q4 * 8);
            aS[ks] = ldsfrag(lds + CA_XT, 64 + mt * 16 + fr, ks * 32 + q4 * 8); }
#pragma unroll
        for (int nn = 0; nn < 2; ++nn) { const int nt = (wave & 1) * 2 + nn, rn = nt * 16 + fr, r0 = mt * 16 + q4 * 4;
            bf16x8 bN[2], bK[2], bMb[2], bMk[2];
#pragma unroll
            for (int ks = 0; ks < 2; ++ks) { bN[ks] = ldsfrag(lds + CA_NBHT, rn, ks * 32 + q4 * 8); bK[ks] = ldsfrag(lds + CA_KHT, rn, ks * 32 + q4 * 8);
                bMb[ks] = ldsfrag(lds + CA_NMRB, rn, ks * 32 + q4 * 8); bMk[ks] = ldsfrag(lds + CA_MRK, rn, ks * 32 + q4 * 8); }
            f32x4 aP = {0.f, 0.f, 0.f, 0.f}, aQ = {0.f, 0.f, 0.f, 0.f}, aR = {0.f, 0.f, 0.f, 0.f}, aY = {0.f, 0.f, 0.f, 0.f};
#pragma unroll
            for (int ks = 0; ks < 2; ++ks) { aP = MFMA16(aX[ks], bN[ks], aP); aQ = MFMA16(aV[ks], bK[ks], aQ); aQ = MFMA16(aS[ks], bN[ks], aQ);
                aR = MFMA16(aX[ks], bMb[ks], aR); aY = MFMA16(aV[ks], bMk[ks], aY); aY = MFMA16(aS[ks], bMb[ks], aY); }
            const float gj = ((LAS float*)(lds + CA_G))[rn];
            *(u32x2*)(PTg + rn * 64 + r0) = pack4(aP[0] + (r0 + 0 == rn ? gj : 0.f), aP[1] + (r0 + 1 == rn ? gj : 0.f), aP[2] + (r0 + 2 == rn ? gj : 0.f), aP[3] + (r0 + 3 == rn ? gj : 0.f));
#pragma unroll
            for (int jj = 0; jj < 4; ++jj) Qg[(r0 + jj) * 64 + rn] = aQ[jj];
            { const u32x2 rt = *(const LAS u32x2*)(lds + CA_RT + rn * 144 + r0 * 2);
              *(u32x2*)(RHg + rn * 64 + r0) = pack4(bflo(rt.x) + aR[0], bfhi(rt.x) + aR[1], bflo(rt.y) + aR[2], bfhi(rt.y) + aR[3]); }
            *(u32x2*)(Y0g + rn * 64 + r0) = pack4(aY[0], aY[1], aY[2], aY[3]);
        }
    }
    LBAR();
}

constexpr int CB_SH = 0, CB_SL = 9216;
__device__ __forceinline__ void chunkB_item(const Args& A, LAS unsigned char* lds, int tid, int lane, int wave, int bh) {
    const int fr = lane & 15, q4 = lane >> 4, mt = wave >> 1, nt0 = (wave & 1) * 2, v0 = mt * 16 + q4 * 4;
    const int h = bh & 7, b = bh >> 3, colg = h * 64 + v0;
    const bf16_t* Z = (const bf16_t*)(A.ws + WS_Z); bf16_t* MIX = (bf16_t*)(A.ws + WS_XN);
    LAS float* ST = (LAS float*)(lds + 18432);
    f32x4 acc[2] = {{0.f, 0.f, 0.f, 0.f}, {0.f, 0.f, 0.f, 0.f}};
#define B_LOAD(BP, QV, cc) do { const size_t ci_ = (size_t)bh * 32 + (cc); const unsigned char* pq_ = (const unsigned char*)A.out + CH_PQ + ci_ * 24576; \
        const bf16_t* PTg_ = (const bf16_t*)pq_; const float* Qg_ = (const float*)(pq_ + 8192); \
        _Pragma("unroll") for (int nn = 0; nn < 2; ++nn) { const int rn = (nt0 + nn) * 16 + fr; \
            _Pragma("unroll") for (int ks = 0; ks < 2; ++ks) BP[nn][ks] = *(const bf16x8*)(PTg_ + rn * 64 + ks * 32 + q4 * 8); \
            _Pragma("unroll") for (int jj = 0; jj < 4; ++jj) QV[nn][jj] = Qg_[(mt * 16 + q4 * 4 + jj) * 64 + rn]; } } while (0)
#define B_LOADY(bR, y0_, zc_, zp_, zg_, bc_, cc) do { const size_t ci_ = (size_t)bh * 32 + (cc); \
        const bf16_t* RHg_ = (const bf16_t*)(A.ws + WS_RY + ci_ * 16384); const bf16_t* Y0g_ = RHg_ + 4096; const float* BCg_ = (const float*)(A.ws + WS_BC) + ci_ * 64; \
        _Pragma("unroll") for (int nn = 0; nn < 2; ++nn) { const int t = (nt0 + nn) * 16 + fr; const size_t row = (size_t)b * SEQ + (cc) * 64 + t; \
            _Pragma("unroll") for (int ks = 0; ks < 2; ++ks) bR[nn][ks] = *(const bf16x8*)(RHg_ + t * 64 + ks * 32 + q4 * 8); \
            y0_[nn] = *(const u32x2*)(Y0g_ + t * 64 + v0); zc_[nn] = *(const u32x2*)(Z + row * NZ + 1024 + colg); zp_[nn] = (u32x2){0u, 0u}; \
            if (!((cc) == 0 && t == 0)) zp_[nn] = *(const u32x2*)(Z + (row - 1) * NZ + 1024 + colg); \
            zg_[nn] = *(const u32x2*)(Z + row * NZ + O_GR + colg); bc_[nn] = BCg_[t]; } } while (0)
#define B_STEP(BP, QV, bR, y0_, zc_, zp_, zg_, bc_, cc) do { \
        const f32x4 lnw = *(const f32x4*)(A.ln_w + colg), lnb = *(const f32x4*)(A.ln_b + colg), muv = *(const f32x4*)(A.mu + 1024 + colg); \
        _Pragma("unroll") for (int nn = 0; nn < 2; ++nn) _Pragma("unroll") for (int jj = 0; jj < 4; ++jj) { const int v = mt * 16 + q4 * 4 + jj, i = (nt0 + nn) * 16 + fr; const float s_ = acc[nn][jj]; \
            const unsigned hi = pk2(s_, 0.f) & 0xffffu; const unsigned lo = pk2(s_ - bf2f(hi), 0.f) & 0xffffu; \
            *(LAS unsigned short*)(lds + CB_SH + v * 144 + i * 2) = (unsigned short)hi; *(LAS unsigned short*)(lds + CB_SL + v * 144 + i * 2) = (unsigned short)lo; } \
        LBAR(); \
        bf16x8 aH[2], aL[2]; \
        _Pragma("unroll") for (int ks = 0; ks < 2; ++ks) { aH[ks] = ldsfrag(lds + CB_SH, mt * 16 + fr, ks * 32 + q4 * 8); aL[ks] = ldsfrag(lds + CB_SL, mt * 16 + fr, ks * 32 + q4 * 8); } \
        float y_[2][4]; \
        _Pragma("unroll") for (int nn = 0; nn < 2; ++nn) { f32x4 an = QV[nn], ya = {0.f, 0.f, 0.f, 0.f}; \
            _Pragma("unroll") for (int ks = 0; ks < 2; ++ks) { an = MFMA16(aH[ks], BP[nn][ks], an); an = MFMA16(aL[ks], BP[nn][ks], an); ya = MFMA16(aH[ks], bR[nn][ks], ya); } \
            acc[nn] = an; const int t = (nt0 + nn) * 16 + fr; \
            y_[nn][0] = ya[0] + bflo(y0_[nn].x); y_[nn][1] = ya[1] + bfhi(y0_[nn].x); y_[nn][2] = ya[2] + bflo(y0_[nn].y); y_[nn][3] = ya[3] + bfhi(y0_[nn].y); \
            float s1 = (y_[nn][0] + y_[nn][1]) + (y_[nn][2] + y_[nn][3]), s2 = (y_[nn][0] * y_[nn][0] + y_[nn][1] * y_[nn][1]) + (y_[nn][2] * y_[nn][2] + y_[nn][3] * y_[nn][3]); \
            s1 += __shfl_xor(s1, 16); s1 += __shfl_xor(s1, 32); s2 += __shfl_xor(s2, 16); s2 += __shfl_xor(s2, 32); \
            if (q4 == 0) { ST[(mt * 64 + t) * 2] = s1; ST[(mt * 64 + t) * 2 + 1] = s2; } } \
        LBAR(); \
        _Pragma("unroll") for (int nn = 0; nn < 2; ++nn) { const int t = (nt0 + nn) * 16 + fr; float s1 = 0.f, s2 = 0.f; \
            _Pragma("unroll") for (int m = 0; m < 4; ++m) { s1 += ST[(m * 64 + t) * 2]; s2 += ST[(m * 64 + t) * 2 + 1]; } \
            const float mean = s1 * (1.f / 64.f); const float var = fmaxf(s2 * (1.f / 64.f) - mean * mean, 0.f); const float rstd = __builtin_amdgcn_rsqf(var + GN_EPS); \
            const size_t row = (size_t)b * SEQ + (cc) * 64 + t; \
            const float cv[4] = {bflo(zc_[nn].x), bfhi(zc_[nn].x), bflo(zc_[nn].y), bfhi(zc_[nn].y)}, pv[4] = {bflo(zp_[nn].x), bfhi(zp_[nn].x), bflo(zp_[nn].y), bfhi(zp_[nn].y)}, \
                        gv[4] = {bflo(zg_[nn].x), bfhi(zg_[nn].x), bflo(zg_[nn].y), bfhi(zg_[nn].y)}; \
            float o[4]; \
            _Pragma("unroll") for (int jj = 0; jj < 4; ++jj) { const float yn = (y_[nn][jj] - mean) * rstd * lnw[jj] + lnb[jj]; const float zsv = cv[jj] + muv[jj] * (pv[jj] - cv[jj]); \
                o[jj] = (yn + bc_[nn] * zsv) * siluf_(gv[jj]); } \
            *(u32x2*)(MIX + row * DM + colg) = pack4(o[0], o[1], o[2], o[3]); } } while (0)
    bf16x8 p0[2][2], p1[2][2]; f32x4 q0[2], q1[2];
    bf16x8 r0_[2][2], r1_[2][2]; u32x2 ya0[2], ya1[2], zc0[2], zc1[2], zp0[2], zp1[2], zg0[2], zg1[2]; float bc0[2], bc1[2];
    B_LOAD(p0, q0, 0); B_LOADY(r0_, ya0, zc0, zp0, zg0, bc0, 0);
#pragma unroll 1
    for (int c = 0; c < 32; ++c) {
        const int cn = c + 1 < 32 ? c + 1 : 31;
        B_LOAD(p1, q1, cn); B_LOADY(r1_, ya1, zc1, zp1, zg1, bc1, cn);
        B_STEP(p0, q0, r0_, ya0, zc0, zp0, zg0, bc0, c);
#pragma unroll
        for (int nn = 0; nn < 2; ++nn) { p0[nn][0] = p1[nn][0]; p0[nn][1] = p1[nn][1]; q0[nn] = q1[nn]; r0_[nn][0] = r1_[nn][0]; r0_[nn][1] = r1_[nn][1];
            ya0[nn] = ya1[nn]; zc0[nn] = zc1[nn]; zp0[nn] = zp1[nn]; zg0[nn] = zg1[nn]; bc0[nn] = bc1[nn]; }
    }
#undef B_LOAD
#undef B_LOADY
#undef B_STEP
    float* wo = A.out + OUT_WKVP + (size_t)bh * 4096;
#pragma unroll
    for (int nn = 0; nn < 2; ++nn)
#pragma unroll
        for (int jj = 0; jj < 4; ++jj) wo[(mt * 16 + q4 * 4 + jj) * 64 + (nt0 + nn) * 16 + fr] = acc[nn][jj];
    if ((bh & 7) == 0) { const size_t row = (size_t)b * SEQ + SEQ - 1; float* so = A.out + OUT_SHP + (size_t)b * SHIFT;
        for (int cix = tid; cix < SHIFT; cix += 512) so[cix] = bf2f(Z[row * NZ + cix]); }
    LBAR();
}

__device__ __forceinline__ void chunkC_item(const Args& A, LAS unsigned char* lds, int tid, int lane, int wave, int ci) {
    const int c = ci & 31, h = (ci >> 5) & 7, b = ci >> 8;
    const bf16_t* Z = (const bf16_t*)(A.ws + WS_Z); bf16_t* MIX = (bf16_t*)(A.ws + WS_XN);
    const int fr = lane & 15, q4 = lane >> 4, mt = wave >> 1, nt0 = (wave & 1) * 2, v0 = mt * 16 + q4 * 4;
    const bf16_t* Sg = (const bf16_t*)((const unsigned char*)A.out + CH_S + (size_t)ci * 8192);
    const bf16_t* RHg = (const bf16_t*)(A.ws + WS_RY + (size_t)ci * 16384); const bf16_t* Y0g = RHg + 4096;
    const float* BCg = (const float*)(A.ws + WS_BC) + (size_t)ci * 64;
    LAS float* ST = (LAS float*)lds;
    bf16x8 aS[2];
#pragma unroll
    for (int ks = 0; ks < 2; ++ks) aS[ks] = *(const bf16x8*)(Sg + (mt * 16 + fr) * 64 + ks * 32 + q4 * 8);
    const int colg = h * 64 + v0;
    u32x2 zcA[2], zpA[2], zgA[2]; float bcA[2];
#pragma unroll
    for (int nn = 0; nn < 2; ++nn) { const int t = (nt0 + nn) * 16 + fr; const size_t row = (size_t)b * SEQ + c * 64 + t;
        zcA[nn] = *(const u32x2*)(Z + row * NZ + 1024 + colg); zpA[nn] = (u32x2){0u, 0u}; if (!(c == 0 && t == 0)) zpA[nn] = *(const u32x2*)(Z + (row - 1) * NZ + 1024 + colg);
        zgA[nn] = *(const u32x2*)(Z + row * NZ + O_GR + colg); bcA[nn] = BCg[t]; }
    const f32x4 lnw = *(const f32x4*)(A.ln_w + colg), lnb = *(const f32x4*)(A.ln_b + colg), muv = *(const f32x4*)(A.mu + 1024 + colg);
    float y[2][4];
#pragma unroll
    for (int nn = 0; nn < 2; ++nn) { const int t = (nt0 + nn) * 16 + fr; f32x4 acc = {0.f, 0.f, 0.f, 0.f};
#pragma unroll
        for (int ks = 0; ks < 2; ++ks) acc = MFMA16(aS[ks], *(const bf16x8*)(RHg + t * 64 + ks * 32 + q4 * 8), acc);
        const u32x2 y0 = *(const u32x2*)(Y0g + t * 64 + v0);
        y[nn][0] = acc[0] + bflo(y0.x); y[nn][1] = acc[1] + bfhi(y0.x); y[nn][2] = acc[2] + bflo(y0.y); y[nn][3] = acc[3] + bfhi(y0.y);
        float s1 = (y[nn][0] + y[nn][1]) + (y[nn][2] + y[nn][3]), s2 = (y[nn][0] * y[nn][0] + y[nn][1] * y[nn][1]) + (y[nn][2] * y[nn][2] + y[nn][3] * y[nn][3]);
        s1 += __shfl_xor(s1, 16); s1 += __shfl_xor(s1, 32); s2 += __shfl_xor(s2, 16); s2 += __shfl_xor(s2, 32);
        if (q4 == 0) { ST[(mt * 64 + t) * 2] = s1; ST[(mt * 64 + t) * 2 + 1] = s2; } }
    LBAR();
#pragma unroll
    for (int nn = 0; nn < 2; ++nn) { const int t = (nt0 + nn) * 16 + fr; float s1 = 0.f, s2 = 0.f;
#pragma unroll
        for (int m = 0; m < 4; ++m) { s1 += ST[(m * 64 + t) * 2]; s2 += ST[(m * 64 + t) * 2 + 1]; }
        const float mean = s1 * (1.f / 64.f); const float var = fmaxf(s2 * (1.f / 64.f) - mean * mean, 0.f); const float rstd = __builtin_amdgcn_rsqf(var + GN_EPS);
        const size_t row = (size_t)b * SEQ + c * 64 + t;
        const u32x2 zc = zcA[nn], zp = zpA[nn], zg = zgA[nn];
        const float cv[4] = {bflo(zc.x), bfhi(zc.x), bflo(zc.y), bfhi(zc.y)}, pv[4] = {bflo(zp.x), bfhi(zp.x), bflo(zp.y), bfhi(zp.y)}, gv[4] = {bflo(zg.x), bfhi(zg.x), bflo(zg.y), bfhi(zg.y)};
        const float bc = bcA[nn]; float o[4];
#pragma unroll
        for (int jj = 0; jj < 4; ++jj) { const float yn = (y[nn][jj] - mean) * rstd * lnw[jj] + lnb[jj]; const float zsv = cv[jj] + muv[jj] * (pv[jj] - cv[jj]);
            o[jj] = (yn + bc * zsv) * siluf_(gv[jj]); }
        *(u32x2*)(MIX + row * DM + colg) = pack4(o[0], o[1], o[2], o[3]); }
    LBAR();
}

constexpr int AT_K = 0, AT_V = 36864, AT_P = 70656;
__device__ __forceinline__ void attn_prompt_item(const Args& A, LAS unsigned char* lds, int tid, int lane, int wave, int b, int nb, int kvh) {
    const bf16_t* Z = (const bf16_t*)(A.ws + WS_Z); bf16_t* MIX = (bf16_t*)(A.ws + WS_XN);
    const float* ct = (const float*)(A.ws + WS_ROPE); const float* st = ct + 2056 * 8;
    const int fr = lane & 15, q4 = lane >> 4;
    for (int idx = tid; idx < 2048; idx += 512) {
        const int key = idx & 255, ch = idx >> 8; const int pos = (nb - 1) * 128 + key;
        float kf[8], vf[8];
        if (pos >= 0) {
            const size_t row = (size_t)b * SEQ + pos; const bf16_t* kp = Z + row * NZ + O_K + kvh * 64;
            unpack8(*(const u32x4*)(kp + ch * 8), kf); unpack8(*(const u32x4*)(Z + row * NZ + O_V + kvh * 64 + ch * 8), vf);
            if (ch < 2) { float pf[8]; unpack8(*(const u32x4*)(kp + (ch ^ 1) * 8), pf);
#pragma unroll
                for (int i = 0; i < 8; ++i) { const float c = ct[pos * 8 + i], s = st[pos * 8 + i]; kf[i] = ch == 0 ? kf[i] * c - pf[i] * s : kf[i] * c + pf[i] * s; } }
            if (nb == NB - 1 && key >= 128) {
                float* ko = A.out + OUT_KP + ((size_t)(b * 128 + key - 128) * 2 + kvh) * 64 + ch * 8; float* vo = A.out + OUT_VP + ((size_t)(b * 128 + key - 128) * 2 + kvh) * 64 + ch * 8;
                *(f32x4*)ko = (f32x4){kf[0], kf[1], kf[2], kf[3]}; *(f32x4*)(ko + 4) = (f32x4){kf[4], kf[5], kf[6], kf[7]};
                *(f32x4*)vo = (f32x4){vf[0], vf[1], vf[2], vf[3]}; *(f32x4*)(vo + 4) = (f32x4){vf[4], vf[5], vf[6], vf[7]};
            }
        } else {
#pragma unroll
            for (int i = 0; i < 8; ++i) { kf[i] = 0.f; vf[i] = 0.f; }
        }
        *(LAS u32x4*)(lds + AT_K + key * 144 + ch * 16) = pack8(kf);
#pragma unroll
        for (int i = 0; i < 8; ++i) *(LAS unsigned short*)(lds + AT_V + (ch * 8 + i) * 528 + key * 2) = (unsigned short)f2bf(vf[i]);
    }
    __syncthreads();
    LAS unsigned char* Pw = lds + AT_P + wave * 2304;
    for (int task = wave; task < 16; task += 8) {
        const int g = task >> 2, tt = task & 3, hq = kvh * 4 + g;
        const float sink = A.sinks[hq] * 1.4426950408889634f;
        bf16x8 Qf[2][2];
#pragma unroll
        for (int mt = 0; mt < 2; ++mt)
#pragma unroll
            for (int ks = 0; ks < 2; ++ks) {
                const int tq = tt * 32 + mt * 16 + fr; const int pos = nb * 128 + tq; const size_t row = (size_t)b * SEQ + pos;
                const bf16_t* qp = Z + row * NZ + O_Q + hq * 64; const int d0 = ks * 32 + q4 * 8;
                float qf[8]; unpack8(*(const u32x4*)(qp + d0), qf);
                if (ks == 0 && q4 < 2) { float pf[8]; unpack8(*(const u32x4*)(qp + (d0 ^ 8)), pf);
#pragma unroll
                    for (int i = 0; i < 8; ++i) { const float c = ct[pos * 8 + i], s = st[pos * 8 + i]; qf[i] = q4 == 0 ? qf[i] * c - pf[i] * s : qf[i] * c + pf[i] * s; } }
#pragma unroll
                for (int i = 0; i < 8; ++i) qf[i] *= 0.18033688011112042f;
                Qf[mt][ks] = __builtin_bit_cast(bf16x8, pack8(qf));
            }
        float mrow[2][4], lrow[2][4]; f32x4 O[2][4];
#pragma unroll
        for (int mt = 0; mt < 2; ++mt) {
#pragma unroll
            for (int j = 0; j < 4; ++j) { mrow[mt][j] = sink; lrow[mt][j] = 1.f; }
#pragma unroll
            for (int dt = 0; dt < 4; ++dt) O[mt][dt] = (f32x4){0.f, 0.f, 0.f, 0.f};
        }
        unsigned short gts[2][4][4];
#pragma unroll
        for (int mt = 0; mt < 2; ++mt)
#pragma unroll
            for (int j = 0; j < 4; ++j) { const size_t row = (size_t)b * SEQ + nb * 128 + tt * 32 + mt * 16 + q4 * 4 + j;
#pragma unroll
                for (int dt = 0; dt < 4; ++dt) gts[mt][j][dt] = Z[row * NZ + O_GA + hq * 64 + dt * 16 + fr]; }
        int kc_lo = tt < 2 ? 0 : 1; const int kc_hi = kc_lo + 3; if (nb == 0 && kc_lo < 2) kc_lo = 2;
        for (int kc = kc_lo; kc < kc_hi; ++kc) {
#pragma unroll
            for (int mt = 0; mt < 2; ++mt) {
                f32x4 S[4];
#pragma unroll
                for (int nt = 0; nt < 4; ++nt) {
                    f32x4 acc = {0.f, 0.f, 0.f, 0.f};
#pragma unroll
                    for (int ks = 0; ks < 2; ++ks) { const bf16x8 Bk = *(const LAS bf16x8*)(lds + AT_K + (kc * 64 + nt * 16 + fr) * 144 + (ks * 32 + q4 * 8) * 2);
                        acc = __builtin_amdgcn_mfma_f32_16x16x32_bf16(Qf[mt][ks], Bk, acc, 0, 0, 0); }
                    S[nt] = acc;
                }
                float alpha[4];
#pragma unroll
                for (int j = 0; j < 4; ++j) {
                    const int dq = kc * 64 + fr - (tt * 32 + mt * 16 + q4 * 4 + j) - 1;
                    float mx = -1e30f;
#pragma unroll
                    for (int nt = 0; nt < 4; ++nt) { const bool ok = (unsigned)(dq + nt * 16) < 128u;
                        const float s = ok ? S[nt][j] : -1e30f; S[nt][j] = s; mx = fmaxf(mx, s); }
                    mx = red16_max(mx);
                    const float mn = fmaxf(mrow[mt][j], mx); alpha[j] = __builtin_amdgcn_exp2f(mrow[mt][j] - mn); mrow[mt][j] = mn;
                    float rs = 0.f;
#pragma unroll
                    for (int nt = 0; nt < 4; ++nt) { const float p = __builtin_amdgcn_exp2f(S[nt][j] - mn); S[nt][j] = p; rs += p; }
                    rs = red16_sum(rs); lrow[mt][j] = lrow[mt][j] * alpha[j] + rs;
                }
#pragma unroll
                for (int dt = 0; dt < 4; ++dt)
#pragma unroll
                    for (int j = 0; j < 4; ++j) O[mt][dt][j] *= alpha[j];
#pragma unroll
                for (int nt = 0; nt < 4; ++nt)
#pragma unroll
                    for (int j = 0; j < 4; ++j) *(LAS unsigned short*)(Pw + (q4 * 4 + j) * 144 + (nt * 16 + fr) * 2) = (unsigned short)f2bf(S[nt][j]);
                LDS_WAIT();
                bf16x8 Pa[2];
#pragma unroll
                for (int ks = 0; ks < 2; ++ks) Pa[ks] = *(const LAS bf16x8*)(Pw + fr * 144 + (ks * 32 + q4 * 8) * 2);
#pragma unroll
                for (int dt = 0; dt < 4; ++dt)
#pragma unroll
                    for (int ks = 0; ks < 2; ++ks) { const bf16x8 Bv = *(const LAS bf16x8*)(lds + AT_V + (dt * 16 + fr) * 528 + (kc * 64 + ks * 32 + q4 * 8) * 2);
                        O[mt][dt] = __builtin_amdgcn_mfma_f32_16x16x32_bf16(Pa[ks], Bv, O[mt][dt], 0, 0, 0); }
                LDS_WAIT();
            }
        }
#pragma unroll
        for (int mt = 0; mt < 2; ++mt)
#pragma unroll
            for (int j = 0; j < 4; ++j) {
                const int tq = tt * 32 + mt * 16 + q4 * 4 + j; const size_t row = (size_t)b * SEQ + nb * 128 + tq; const float il = __builtin_amdgcn_rcpf(lrow[mt][j]);
#pragma unroll
                for (int dt = 0; dt < 4; ++dt) { const int d = dt * 16 + fr; const float g = bf2f(gts[mt][j][dt]);
                    MIX[row * DM + 512 + hq * 64 + d] = (bf16_t)f2bf(O[mt][dt][j] * il * siluf_(g)); }
            }
    }
    __syncthreads();
}

constexpr int SA_K = 0, SA_V = 35456, SA_Q = 72448, SA_P = 80640;
__device__ __forceinline__ void attn_sample_item(const Args& A, LAS unsigned char* lds, int tid, int lane, int wave, int b, int kvh) {
    const bf16_t* Z = (const bf16_t*)(A.ws + WS_Z); bf16_t* MIX = (bf16_t*)(A.ws + WS_XN);
    const float* ct = (const float*)(A.ws + WS_ROPE); const float* st = ct + 2056 * 8;
    LAS float* SK = (LAS float*)(lds + SA_K); LAS float* SV = (LAS float*)(lds + SA_V); LAS float* SQ = (LAS float*)(lds + SA_Q); LAS float* SP = (LAS float*)(lds + SA_P);
    float* ko = A.out + OUT_KS + (size_t)b * 128 * 128; float* vo = A.out + OUT_VS + (size_t)b * 128 * 128;
    {
        f32x4 kq[4], vq[4];
#pragma unroll
        for (int i = 0; i < 4; ++i) { const int idx = tid + 512 * i, w = idx >> 4, d4 = (idx & 15) * 4; const size_t gi = ((size_t)(b * 128 + w) * 2 + kvh) * 64 + d4;
            kq[i] = *(const f32x4*)(A.cache_k + gi); vq[i] = *(const f32x4*)(A.cache_v + gi); }
#pragma unroll
        for (int i = 0; i < 4; ++i) { const int idx = tid + 512 * i, w = idx >> 4, d4 = (idx & 15) * 4;
            SK[w * 65 + d4] = kq[i].x; SK[w * 65 + d4 + 1] = kq[i].y; SK[w * 65 + d4 + 2] = kq[i].z; SK[w * 65 + d4 + 3] = kq[i].w;
            *(LAS f32x4*)(SV + w * 68 + d4) = vq[i];
            if (w >= 8) { *(f32x4*)(ko + ((w - 8) * 2 + kvh) * 64 + d4) = kq[i]; *(f32x4*)(vo + ((w - 8) * 2 + kvh) * 64 + d4) = vq[i]; } }
    }
    {
        const int t = tid >> 6, d = tid & 63; const size_t row = (size_t)MP + b * 8 + t; const bf16_t* kp = Z + row * NZ + O_K + kvh * 64;
        float kv = bf2f(kp[d]); const int pi = 2048 + t;
        if (d < 16) { const float pr = bf2f(kp[d ^ 8]); const float c = ct[pi * 8 + (d & 7)], s = st[pi * 8 + (d & 7)]; kv = d < 8 ? kv * c - pr * s : kv * c + pr * s; }
        const float vv = bf2f(Z[row * NZ + O_V + kvh * 64 + d]);
        SK[(128 + t) * 65 + d] = kv; SV[(128 + t) * 68 + d] = vv;
        ko[((120 + t) * 2 + kvh) * 64 + d] = kv; vo[((120 + t) * 2 + kvh) * 64 + d] = vv;
    }
    for (int idx = tid; idx < 32 * 64; idx += 512) {
        const int qi = idx >> 6, d = idx & 63, t = qi >> 2, g = qi & 3, hq = kvh * 4 + g; const size_t row = (size_t)MP + b * 8 + t; const bf16_t* qp = Z + row * NZ + O_Q + hq * 64;
        float qv = bf2f(qp[d]); const int pi = 2048 + t;
        if (d < 16) { const float pr = bf2f(qp[d ^ 8]); const float c = ct[pi * 8 + (d & 7)], s = st[pi * 8 + (d & 7)]; qv = d < 8 ? qv * c - pr * s : qv * c + pr * s; }
        SQ[qi * 64 + d] = qv * 0.125f;
    }
    __syncthreads();
    for (int idx = tid; idx < 32 * 136; idx += 512) {
        const int qi = idx / 136, ki = idx % 136, t = qi >> 2;
        const bool ok = ki < 128 ? (ki >= t + 1) : (ki - 128 <= t);
        float dot = 0.f;
#pragma unroll 8
        for (int d = 0; d < 64; ++d) dot += SQ[qi * 64 + d] * SK[ki * 65 + d];
        SP[qi * 136 + ki] = ok ? dot : -1e30f;
    }
    __syncthreads();
#pragma unroll
    for (int i = 0; i < 4; ++i) {
        const int qi = wave * 4 + i, g = qi & 3; const float sink = A.sinks[kvh * 4 + g];
        const float s0 = SP[qi * 136 + lane], s1 = SP[qi * 136 + 64 + lane], s2 = lane < 8 ? SP[qi * 136 + 128 + lane] : -1e30f;
        float mx = fmaxf(fmaxf(s0, s1), fmaxf(s2, sink));
#pragma unroll
        for (int o = 1; o < 64; o <<= 1) mx = fmaxf(mx, __shfl_xor(mx, o));
        const float p0 = __expf(s0 - mx), p1 = __expf(s1 - mx), p2 = __expf(s2 - mx);
        const float den = wave_sum(p0 + p1 + p2) + __expf(sink - mx); const float il = __builtin_amdgcn_rcpf(den);
        SP[qi * 136 + lane] = p0 * il; SP[qi * 136 + 64 + lane] = p1 * il; if (lane < 8) SP[qi * 136 + 128 + lane] = p2 * il;
    }
    __syncthreads();
    {
        const int qi = tid >> 4, d0 = (tid & 15) * 4, t = qi >> 2, g = qi & 3, hq = kvh * 4 + g;
        f32x4 acc = {0.f, 0.f, 0.f, 0.f};
        for (int k = 0; k < 136; ++k) { const float p = SP[qi * 136 + k]; const f32x4 v = *(const LAS f32x4*)(SV + k * 68 + d0); acc += p * v; }
        const size_t row = (size_t)MP + b * 8 + t;
#pragma unroll
        for (int e = 0; e < 4; ++e) { const float gte = bf2f(Z[row * NZ + O_GA + hq * 64 + d0 + e]); MIX[row * DM + 512 + hq * 64 + d0 + e] = (bf16_t)f2bf(acc[e] * siluf_(gte)); }
    }
    __syncthreads();
}


__device__ __forceinline__ void grid_bar(unsigned* cnt, unsigned target) {
    asm volatile("s_waitcnt vmcnt(0)" ::: "memory");
    __syncthreads();
    if (threadIdx.x == 0) {
        __builtin_amdgcn_fence(__ATOMIC_RELEASE, "agent");
        asm volatile("s_waitcnt vmcnt(0)" ::: "memory");
        __hip_atomic_fetch_add(cnt, 1u, __ATOMIC_RELAXED, __HIP_MEMORY_SCOPE_AGENT);
        while (__hip_atomic_load(cnt, __ATOMIC_RELAXED, __HIP_MEMORY_SCOPE_AGENT) < target) __builtin_amdgcn_s_sleep(1);
        __builtin_amdgcn_fence(__ATOMIC_ACQUIRE, "agent");
        asm volatile("s_waitcnt vmcnt(0)" ::: "memory");
    }
    __syncthreads();
}


__device__ __forceinline__ void small_gemm(const bf16_t* Ab, int lda, const bf16_t* Bt, int ldb, int K, int row0, int col0, int lane, int wave, f32x4 (&acc)[2]) {
    const int fr = lane & 15, q4 = lane >> 4, mt = wave >> 1, nt0 = (wave & 1) * 2;
    const bf16_t* ap = Ab + (size_t)(row0 + mt * 16 + fr) * lda + q4 * 8;
    const bf16_t* bp0 = Bt + (size_t)(col0 + nt0 * 16 + fr) * ldb + q4 * 8; const bf16_t* bp1 = bp0 + (size_t)16 * ldb;
    acc[0] = (f32x4){0.f, 0.f, 0.f, 0.f}; acc[1] = (f32x4){0.f, 0.f, 0.f, 0.f};
    for (int k = 0; k < K; k += 256) {
        bf16x8 a[8], b0[8], b1[8];
#pragma unroll
        for (int i = 0; i < 8; ++i) { a[i] = *(const bf16x8*)(ap + k + 32 * i); b0[i] = *(const bf16x8*)(bp0 + k + 32 * i); b1[i] = *(const bf16x8*)(bp1 + k + 32 * i); }
        __builtin_amdgcn_sched_barrier(0);
#pragma unroll
        for (int i = 0; i < 8; ++i) { acc[0] = MFMA16(a[i], b0[i], acc[0]); acc[1] = MFMA16(a[i], b1[i], acc[1]); }
        __builtin_amdgcn_sched_barrier(0);
    }
}

__global__ void __launch_bounds__(512, 2) hymba_fwd(Args A) {
    extern __shared__ __attribute__((aligned(16))) unsigned char lds_raw[];
    LAS unsigned char* lds = (LAS unsigned char*)lds_raw;
    cg::grid_group grid = cg::this_grid();
    const int tid = threadIdx.x, lane = tid & 63, wave = __builtin_amdgcn_readfirstlane(tid >> 6);
    unsigned char* ws = A.ws;
    unsigned* ctl = (unsigned*)(ws + WS_CTL);
    float* rowss2 = (float*)(ctl + CW_SS2); float* rowss3 = (float*)(ctl + CW_SS3);
    bf16_t* Win_t = (bf16_t*)(ws + WS_WIN); bf16_t* Wout_t = (bf16_t*)(ws + WS_WOUT); bf16_t* Wpg_t = (bf16_t*)(ws + WS_WPG); bf16_t* Wpp_t = (bf16_t*)(ws + WS_WPP);
    bf16_t* XN = (bf16_t*)(ws + WS_XN); bf16_t* PB = (bf16_t*)(ws + WS_PB); bf16_t* PP = (bf16_t*)(ws + WS_PP); bf16_t* Zb = (bf16_t*)(ws + WS_Z);
    bf16_t* MIX = XN; bf16_t* H2B = Zb;

    unsigned bar_k = 0u;
#ifndef NO_P0
    p0_prologue(A, lds, tid, lane, wave);
#endif
    grid.sync();
#ifndef NO_P1
    {
        pg8::Gemm g{XN, Win_t, MTOT, NZ, DM}; pg8::StaticOrder S; S.init(MTOT, NZ, (int)gridDim.x, (int)blockIdx.x);
        pg8::EpiBf16 E{Zb, NZ};
        pg8::gemm_phase<pg8::EpiBf16, pg8::StaticOrder, true, true>(lds, g, S, E);
    }
    {
        const int G = (int)gridDim.x, tail = ((MTOT / 256) * (NZ / 256)) % G;
        pg8::Gemm g{PB, Wpp_t, MTOT, DM, PLE}; pg8::StaticOrder S;
        if (tail * 2 < G) S.init(MTOT, DM, G - tail, (int)blockIdx.x >= tail ? (int)blockIdx.x - tail : (1 << 28)); else S.init(MTOT, DM, G, (int)blockIdx.x);
        pg8::EpiBf16 E{PP, DM};
        pg8::gemm_phase<pg8::EpiBf16, pg8::StaticOrder, true, true>(lds, g, S, E);
    }
#endif
    grid_bar(ctl + CW_BAR, (unsigned)gridDim.x * (++bar_k));
#ifndef NO_P2
    {
        LAS int* s_item = (LAS int*)(lds + LDS_BYTES - 16);
        constexpr int N_CH = 4096, N_PB = 128, N_PA = 512, N_SA = 256, N_SS = 1024;
        { HeadConstA HC; HC.h = -1;
          for (int it = blockIdx.x; it < N_CH; it += gridDim.x) chunkA_item(A, lds, tid, lane, wave, it, it + (int)gridDim.x, HC); }
        grid_bar(ctl + CW_BAR, (unsigned)gridDim.x * (++bar_k));
        for (;;) {
            if (tid == 0) *s_item = (int)atomicAdd(ctl + CW_WORK + 1, 1u);
            __syncthreads();
            const int it = *s_item;
            __syncthreads();
            if (it >= N_PB) break;
            chunkB_item(A, lds, tid, lane, wave, it);
        }
        for (;;) {
            if (tid == 0) *s_item = (int)atomicAdd(ctl + CW_WORK + 3, 1u);
            __syncthreads();
            const int r = *s_item;
            __syncthreads();
            if (r >= N_PA) break;
            const int kvh = r & 1, nb = (r >> 1) & 15, b = r >> 5;
            attn_prompt_item(A, lds, tid, lane, wave, b, nb, kvh);
        }
        for (;;) {
            if (tid == 0) *s_item = (int)atomicAdd(ctl + CW_WORK + 2, 1u);
            __syncthreads();
            const int r = *s_item;
            __syncthreads();
            if (r >= 256) break;
            sscan_item(A, lds, tid, lane, wave, r >> 3, r & 7);
        }
        for (;;) {
            if (tid == 0) *s_item = (int)atomicAdd(ctl + CW_WORK + 4, 1u);
            __syncthreads();
            const int r = *s_item;
            __syncthreads();
            if (r >= N_SA) break;
            attn_sample_item(A, lds, tid, lane, wave, r >> 1, r & 1);
        }
    }
#endif
    grid_bar(ctl + CW_BAR, (unsigned)gridDim.x * (++bar_k));
#ifndef NO_P3
    {
        pg8::Gemm g{MIX, Wout_t, MP, DM, DM}; pg8::StaticOrder S; S.init(MP, DM, (int)gridDim.x, (int)blockIdx.x);
        pg8::EpiRes E{A.x_prompt, A.x_sample, A.out, H2B, rowss2};
        pg8::gemm_phase<pg8::EpiRes, pg8::StaticOrder, true, true>(lds, g, S, E);
    }
    {
        const int fr = lane & 15, q4 = lane >> 4;
        for (int tile = blockIdx.x; tile < 256; tile += gridDim.x) {
            const int row0 = MP + (tile >> 4) * 64, col0 = (tile & 15) * 64; f32x4 acc[2];
            small_gemm(MIX, DM, Wout_t, DM, DM, row0, col0, lane, wave, acc);
#pragma unroll
            for (int jj = 0; jj < 4; ++jj) { const int row = row0 + (wave >> 1) * 16 + q4 * 4 + jj; float ss = 0.f;
#pragma unroll
                for (int nn = 0; nn < 2; ++nn) { const int col = col0 + ((wave & 1) * 2 + nn) * 16 + fr; const float v = acc[nn][jj] + A.x_sample[(size_t)(row - MP) * DM + col];
                    H2B[(size_t)row * DM + col] = (bf16_t)f2bf(v); ss += v * v; }
                ss = red16_sum(ss); if (fr == 0) atomicAdd(rowss2 + row, ss); }
        }
    }
#endif
    grid_bar(ctl + CW_BAR, (unsigned)gridDim.x * (++bar_k));
#ifndef NO_P4
    {
        pg8::Gemm g{H2B, Wpg_t, MP, DM, DM}; pg8::StaticOrder S; S.init(MP, DM, (int)gridDim.x, (int)blockIdx.x);
        pg8::EpiGate E{H2B, XN, PP, rowss2, rowss3};
        pg8::gemm_phase<pg8::EpiGate, pg8::StaticOrder, true, true>(lds, g, S, E);
    }
    {
        const int fr = lane & 15, q4 = lane >> 4;
        for (int tile = blockIdx.x; tile < 256; tile += gridDim.x) {
            const int row0 = MP + (tile >> 4) * 64, col0 = (tile & 15) * 64; f32x4 acc[2];
            small_gemm(H2B, DM, Wpg_t, DM, DM, row0, col0, lane, wave, acc);
#pragma unroll
            for (int jj = 0; jj < 4; ++jj) { const int row = row0 + (wave >> 1) * 16 + q4 * 4 + jj; float ss = 0.f;
                const float rstd = __builtin_amdgcn_rsqf(rowss2[row] * (1.f / DM) + NORM_EPS);
#pragma unroll
                for (int nn = 0; nn < 2; ++nn) { const int col = col0 + ((wave & 1) * 2 + nn) * 16 + fr; const size_t o = (size_t)row * DM + col;
                    const float v = bf2f(H2B[o]) + sigmoidf_(acc[nn][jj] * rstd) * bf2f(PP[o]); XN[o] = (bf16_t)f2bf(v); ss += v * v; }
                ss = red16_sum(ss); if (fr == 0) atomicAdd(rowss3 + row, ss); }
        }
    }
#endif
    grid_bar(ctl + CW_BAR, (unsigned)gridDim.x * (++bar_k));
    {
        const int gw = blockIdx.x * 8 + wave, NGW = gridDim.x * 8;
        f32x4 gv[4];
#pragma unroll
        for (int j = 0; j < 4; ++j) gv[j] = *((const f32x4*)A.g_final + lane + 64 * j);
        u32x2 hw[4], nh[4]; float rs = 0.f, nrs = 0.f;
        int m = gw;
        if (m < MTOT) { const u32x2* hr = (const u32x2*)(XN + (size_t)m * DM) + lane;
#pragma unroll
            for (int j = 0; j < 4; ++j) hw[j] = hr[64 * j];
            rs = rowss3[m]; }
        for (; m < MTOT; m += NGW) {
            const int mn = m + NGW;
            if (mn < MTOT) { const u32x2* hr = (const u32x2*)(XN + (size_t)mn * DM) + lane;
#pragma unroll
                for (int j = 0; j < 4; ++j) nh[j] = hr[64 * j];
                nrs = rowss3[mn]; }
            const float rstd = __builtin_amdgcn_rsqf(rs * (1.f / DM) + NORM_EPS);
            f32x4* yr = (f32x4*)(A.out + (size_t)m * DM) + lane;
#pragma unroll
            for (int j = 0; j < 4; ++j) { f32x4 v = {bflo(hw[j].x), bfhi(hw[j].x), bflo(hw[j].y), bfhi(hw[j].y)}; v = v * rstd * gv[j]; yr[64 * j] = v; }
#pragma unroll
            for (int j = 0; j < 4; ++j) hw[j] = nh[j];
            rs = nrs;
        }
    }
}

extern "C" void kernel_launch(void* const* d_in, const int* in_sizes, int n_in, void* d_out, int out_size, void* d_ws, size_t ws_size, hipStream_t stream) {
    static int grid = 0;
    if (grid == 0) {
        if (n_in != 26 || ws_size < WS_END) { fprintf(stderr, "kernel_launch: unexpected n_in %d / ws %zu\n", n_in, ws_size); grid = -1; return; }
        int dev = 0, cus = 0, per_cu = 0;
        (void)hipGetDevice(&dev); (void)hipDeviceGetAttribute(&cus, hipDeviceAttributeMultiprocessorCount, dev);
        if (hipFuncSetAttribute((const void*)hymba_fwd, hipFuncAttributeMaxDynamicSharedMemorySize, LDS_BYTES) != hipSuccess) { fprintf(stderr, "kernel_launch: hipFuncSetAttribute failed\n"); grid = -1; return; }
        if (hipOccupancyMaxActiveBlocksPerMultiprocessor(&per_cu, (const void*)hymba_fwd, 512, LDS_BYTES) != hipSuccess || per_cu < 1) { fprintf(stderr, "kernel_launch: occupancy query says %d\n", per_cu); per_cu = 1; }
        (void)hipGetLastError();
        grid = cus * 1;
        if (grid <= 0) grid = 256;
    }
    if (grid < 0) return;
    Args a{};
    const float** pa = (const float**)&a;
    for (int i = 0; i < 26; ++i) pa[i] = (const float*)d_in[i];
    a.out = (float*)d_out; a.ws = (unsigned char*)d_ws;
    void* args[] = {&a};
    hipError_t e = hipLaunchCooperativeKernel((const void*)hymba_fwd, dim3(grid), dim3(512), args, LDS_BYTES, stream);
    if (e != hipSuccess) fprintf(stderr, "cooperative launch failed: %s (grid %d)\n", hipGetErrorString(e), grid);
}
```

```cpp
#include <hip/hip_runtime.h>
#include <hip/hip_cooperative_groups.h>
#include <cstdio>
#include <cstdint>
namespace cg = cooperative_groups;

constexpr int DM = 1024, MP = 32768, MS = 1024, MTOT = MP + MS, SEQ = 2048, NB = 16, DB = 128, DSEQ = 8;
constexpr int NZ = 3584;
constexpr int IN_DIM = 3456, SHIFT = 1664, PLE = 256;
constexpr int O_GR = 1664, O_Q = 2176, O_K = 2688, O_V = 2816, O_GA = 2944;
constexpr float NORM_EPS = 1e-6f, GN_EPS = 64e-5f;
constexpr size_t OUT_Y = 0, OUT_WKVP = (size_t)MTOT * DM, OUT_SHP = OUT_WKVP + 16 * 8 * 4096, OUT_KP = OUT_SHP + 16 * SHIFT,
                 OUT_VP = OUT_KP + 16 * 128 * 128, OUT_WKVS = OUT_VP + 16 * 128 * 128, OUT_SHS = OUT_WKVS + (size_t)128 * 8 * 4096,
                 OUT_KS = OUT_SHS + 128 * SHIFT, OUT_VS = OUT_KS + (size_t)128 * 128 * 128;
constexpr size_t MiB = 1u << 20;
constexpr size_t WS_CTL = 0, CTL_BYTES = 1 * MiB;
constexpr size_t WS_WIN = 1 * MiB;
constexpr size_t WS_WOUT = 8 * MiB, WS_WPG = 10 * MiB, WS_WPP = 12 * MiB;
constexpr size_t WS_ROPE = 13 * MiB;
constexpr size_t WS_XN = 14 * MiB;
constexpr size_t WS_PB = 80 * MiB;
constexpr size_t WS_PP = 97 * MiB;
constexpr size_t WS_Z = 163 * MiB;
constexpr size_t CH_PQ = 0;
constexpr size_t CH_S = 96 * MiB;
constexpr size_t WS_RY = 395 * MiB;
constexpr size_t WS_BC = 459 * MiB;
constexpr size_t WS_W2T = 13 * MiB + 512 * 1024, WS_A2T = 13 * MiB + 640 * 1024;
constexpr size_t WS_END = 461 * MiB;
constexpr int CW_BAR = 512, CW_WORK = 0, CW_SS2 = 1024, CW_SS3 = CW_SS2 + MTOT;
constexpr int LDS_BYTES = 147456;

#define LAS __attribute__((address_space(3)))
typedef unsigned short bf16_t;
typedef short bf16x8 __attribute__((ext_vector_type(8)));
typedef float f32x4 __attribute__((ext_vector_type(4)));
typedef unsigned u32x4 __attribute__((ext_vector_type(4)));
typedef unsigned u32x2 __attribute__((ext_vector_type(2)));

typedef float f32x2_t __attribute__((ext_vector_type(2)));
typedef __bf16 bf16x2_t __attribute__((ext_vector_type(2)));
__device__ __forceinline__ unsigned pk2(float lo, float hi) { f32x2_t v = {lo, hi}; bf16x2_t b = __builtin_convertvector(v, bf16x2_t); return __builtin_bit_cast(unsigned, b); }
__device__ __forceinline__ unsigned f2bf(float f) { return pk2(f, 0.f) & 0xffffu; }
__device__ __forceinline__ float bf2f(unsigned h) { return __builtin_bit_cast(float, h << 16); }
__device__ __forceinline__ float bflo(unsigned u) { return __builtin_bit_cast(float, u << 16); }
__device__ __forceinline__ float bfhi(unsigned u) { return __builtin_bit_cast(float, u & 0xffff0000u); }
__device__ __forceinline__ void unpack8(u32x4 u, float* f) { f[0] = bflo(u.x); f[1] = bfhi(u.x); f[2] = bflo(u.y); f[3] = bfhi(u.y); f[4] = bflo(u.z); f[5] = bfhi(u.z); f[6] = bflo(u.w); f[7] = bfhi(u.w); }
__device__ __forceinline__ u32x4 pack8(const float* f) { u32x4 o; o.x = pk2(f[0], f[1]); o.y = pk2(f[2], f[3]); o.z = pk2(f[4], f[5]); o.w = pk2(f[6], f[7]); return o; }
__device__ __forceinline__ float wave_sum(float v) {
#pragma unroll
    for (int o = 1; o < 64; o <<= 1) v += __shfl_xor(v, o);
    return v;
}
template <int CTRL> __device__ __forceinline__ float dppf(float x) { return __builtin_bit_cast(float, __builtin_amdgcn_update_dpp(0, __builtin_bit_cast(int, x), CTRL, 0xf, 0xf, false)); }
__device__ __forceinline__ float red8_sum(float x) { x += dppf<0xB1>(x); x += dppf<0x4E>(x); x += dppf<0x141>(x); return x; }
__device__ __forceinline__ float red16_sum(float x) { x = red8_sum(x); x += dppf<0x140>(x); return x; }
__device__ __forceinline__ float red16_max(float x) { x = fmaxf(x, dppf<0xB1>(x)); x = fmaxf(x, dppf<0x4E>(x)); x = fmaxf(x, dppf<0x141>(x)); x = fmaxf(x, dppf<0x140>(x)); return x; }
__device__ __forceinline__ float sigmoidf_(float x) { return __builtin_amdgcn_rcpf(1.f + __expf(-x)); }
__device__ __forceinline__ float siluf_(float x) { return x * __builtin_amdgcn_rcpf(1.f + __expf(-x)); }
#define LDS_WAIT() asm volatile("s_waitcnt lgkmcnt(0)" ::: "memory")
#define LBAR() asm volatile("s_waitcnt lgkmcnt(0)\n\ts_barrier" ::: "memory")

namespace pg8 {
constexpr int BM = 256, BK = 64, HALF = 128, HTB = HALF * BK * 2  , STAGE_BYTES = 8 * HTB, NXCD = 8, WGM = 8;

__host__ __device__ __forceinline__ int lds_byte(int r, int c) { const int st = (r >> 4) * 2 + (c >> 5), rr = r & 15, cc = c & 31, ob = rr * 64 + cc * 2; return st * 1024 + (ob ^ (((ob >> 9) & 1) << 5)); }
__host__ __device__ __forceinline__ void stage_rc(int b, int& R, int& C) { const int st = b / 1024, sb = b % 1024, swz = sb ^ (((sb >> 9) & 1) << 5); R = (st >> 1) * 16 + swz / 64; C = (st & 1) * 32 + (swz % 64) / 2; }
__host__ __device__ __forceinline__ int perm32(int rho) { const int n = rho >> 4, i = rho & 15; return 8 * (i >> 2) + 4 * n + (i & 3); }

struct Unit { int pm, pn; };
struct Gemm { const bf16_t* A; const bf16_t* Bt; int M, N, K; };

struct StaticOrder {
    int nM, nN, nwg, G, c;
    __host__ __device__ void init(int M, int N, int G_, int c_) { nM = M / BM; nN = N / BM; nwg = nM * nN; G = G_; c = c_; }
    __host__ __device__ bool next(int i, Unit& u) const {
        const long L = (long)i * G + c; if (L >= nwg) return false;
        int wgid = (int)L; { const int q = nwg / NXCD, r = nwg % NXCD, xcd = wgid % NXCD, off = wgid / NXCD; wgid = (xcd < r ? xcd * (q + 1) : r * (q + 1) + (xcd - r) * q) + off; }
        const int nig = WGM * nN, gid = wgid / nig, fm = gid * WGM, gsz = (nM - fm) < WGM ? (nM - fm) : WGM;
        u.pm = fm + ((wgid % nig) % gsz); u.pn = (wgid % nig) / gsz; return true;
    }
    __device__ __forceinline__ void a_ready(const Unit&) const {}
    __device__ __forceinline__ void done(const Unit&) const {}
};

__device__ __forceinline__ unsigned cvt_pk_bf16(float lo, float hi) { unsigned r; asm volatile("v_cvt_pk_bf16_f32 %0, %1, %2" : "=v"(r) : "v"(lo), "v"(hi)); return r; }

struct EpiBf16 {
    static constexpr bool PERM = true, AFTER_DRAIN = false;
    bf16_t* O; int ldc;
    __device__ __forceinline__ void operator()(const f32x4 (&acc)[2][2][4][2], const Unit& u, int wr, int wc, int fr, int fq) const {
        const int row0 = u.pm * BM + wr * 64 + fr; const int col0 = u.pn * BM + wc * 32 + 8 * fq;
#pragma unroll
        for (int ai = 0; ai < 2; ++ai)
#pragma unroll
            for (int m = 0; m < 4; ++m) { bf16_t* rowp = O + (size_t)(row0 + ai * HALF + m * 16) * ldc + col0;
#pragma unroll
                for (int bj = 0; bj < 2; ++bj) { const f32x4 v0 = acc[ai][bj][m][0], v1 = acc[ai][bj][m][1];
                    u32x4 w; w.x = cvt_pk_bf16(v0[0], v0[1]); w.y = cvt_pk_bf16(v0[2], v0[3]); w.z = cvt_pk_bf16(v1[0], v1[1]); w.w = cvt_pk_bf16(v1[2], v1[3]);
                    *(u32x4*)(rowp + bj * HALF) = w; } }
    }
};

struct EpiRes {
    static constexpr bool PERM = true, AFTER_DRAIN = false;
    const float* xp; const float* xs; float* out; bf16_t* h2b; float* rowss;
    __device__ __forceinline__ void operator()(const f32x4 (&acc)[2][2][4][2], const Unit& u, int wr, int wc, int fr, int fq) const {
        const int row0 = u.pm * BM + wr * 64 + fr; const int col0 = u.pn * BM + wc * 32 + 8 * fq;
#pragma unroll
        for (int ai = 0; ai < 2; ++ai)
#pragma unroll
            for (int m = 0; m < 4; ++m) { const int row = row0 + ai * HALF + m * 16;
                const float* xr = (row < MP ? xp + (size_t)row * DM : xs + (size_t)(row - MP) * DM) + col0;
                bf16_t* brow = h2b + (size_t)row * DM + col0; float ss = 0.f;
#pragma unroll
                for (int bj = 0; bj < 2; ++bj) { const f32x4 x0 = *(const f32x4*)(xr + bj * HALF), x1 = *(const f32x4*)(xr + bj * HALF + 4);
                    const f32x4 v0 = acc[ai][bj][m][0] + x0, v1 = acc[ai][bj][m][1] + x1;
                    u32x4 w; w.x = cvt_pk_bf16(v0[0], v0[1]); w.y = cvt_pk_bf16(v0[2], v0[3]); w.z = cvt_pk_bf16(v1[0], v1[1]); w.w = cvt_pk_bf16(v1[2], v1[3]);
                    *(u32x4*)(brow + bj * HALF) = w;
                    ss += v0[0] * v0[0] + v0[1] * v0[1] + v0[2] * v0[2] + v0[3] * v0[3] + v1[0] * v1[0] + v1[1] * v1[1] + v1[2] * v1[2] + v1[3] * v1[3]; }
                ss += __shfl_xor(ss, 16); ss += __shfl_xor(ss, 32);
                if (fq == 0) atomicAdd(rowss + row, ss); }
    }
};

struct EpiGate {
    static constexpr bool PERM = true, AFTER_DRAIN = false;
    const bf16_t* h2b; bf16_t* h3b; const bf16_t* pp; const float* rowss2; float* rowss3;
    __device__ __forceinline__ void operator()(const f32x4 (&acc)[2][2][4][2], const Unit& u, int wr, int wc, int fr, int fq) const {
        const int row0 = u.pm * BM + wr * 64 + fr; const int col0 = u.pn * BM + wc * 32 + 8 * fq;
#pragma unroll
        for (int ai = 0; ai < 2; ++ai)
#pragma unroll
            for (int m = 0; m < 4; ++m) { const int row = row0 + ai * HALF + m * 16;
                const float rstd = __builtin_amdgcn_rsqf(rowss2[row] * (1.f / DM) + NORM_EPS);
                const bf16_t* hrow = h2b + (size_t)row * DM + col0; bf16_t* orow = h3b + (size_t)row * DM + col0; const bf16_t* prow = pp + (size_t)row * DM + col0; float ss = 0.f;
#pragma unroll
                for (int bj = 0; bj < 2; ++bj) { const u32x4 hw = *(const u32x4*)(hrow + bj * HALF); float hf[8]; unpack8(hw, hf);
                    const u32x4 pw = *(const u32x4*)(prow + bj * HALF); float pf[8]; unpack8(pw, pf);
                    const f32x4 a0 = acc[ai][bj][m][0], a1 = acc[ai][bj][m][1]; f32x4 v0, v1;
#pragma unroll
                    for (int e = 0; e < 4; ++e) { v0[e] = hf[e] + sigmoidf_(a0[e] * rstd) * pf[e]; v1[e] = hf[4 + e] + sigmoidf_(a1[e] * rstd) * pf[4 + e]; }
                    u32x4 w; w.x = cvt_pk_bf16(v0[0], v0[1]); w.y = cvt_pk_bf16(v0[2], v0[3]); w.z = cvt_pk_bf16(v1[0], v1[1]); w.w = cvt_pk_bf16(v1[2], v1[3]);
                    *(u32x4*)(orow + bj * HALF) = w;
                    ss += v0[0] * v0[0] + v0[1] * v0[1] + v0[2] * v0[2] + v0[3] * v0[3] + v1[0] * v1[0] + v1[1] * v1[1] + v1[2] * v1[2] + v1[3] * v1[3]; }
                ss += __shfl_xor(ss, 16); ss += __shfl_xor(ss, 32);
                if (fq == 0) atomicAdd(rowss3 + row, ss); }
    }
};

template <class Epi, class Sched, bool ALIGN_EPI = false, bool SP2 = false>
__device__ __forceinline__ void gemm_phase(LAS unsigned char* lds, const Gemm g, const Sched& S, const Epi& E) {
    const int tid = threadIdx.x, wid = __builtin_amdgcn_readfirstlane(tid >> 6), lane = tid & 63, wr = wid >> 2, wc = wid & 3, fr = lane & 15, fq = lane >> 4;
    const int K = g.K, nt = K / BK;
    unsigned voffA[2], voffB[2];
#pragma unroll
    for (int i = 0; i < 2; ++i) { int R, C; stage_rc(tid * 16 + i * 8192, R, C); const int Rb = Epi::PERM ? ((R & ~31) + perm32(R & 31)) : R;
        voffA[i] = (unsigned)(R * K + C) * 2u; voffB[i] = (unsigned)(Rb * K + C) * 2u; }
    const size_t kstep = (size_t)(BK * 2);
    const size_t hstep = (size_t)HALF * K * 2;
    const size_t tstep = 2 * hstep;
    const unsigned ldsw = (unsigned)wid * 1024u;
    const int aoff = lds_byte(wr * 64 + fr, fq * 8), boff = lds_byte(wc * 32 + fr, fq * 8);
#define PG8_SA(b, h) (((b) * 2 + (h)) * HTB)
#define PG8_SB(b, h) ((4 + (b) * 2 + (h)) * HTB)
#define PG8_STAGE(bufoff, gbase, voff) do { _Pragma("unroll") for (int _i = 0; _i < 2; ++_i) \
        __builtin_amdgcn_global_load_lds((const unsigned*)((const char*)(gbase) + (voff)[_i]), (LAS unsigned*)(lds + (bufoff) + ldsw + _i * 8192), 16, 0, 0); } while (0)
#define PG8_LDA(dst, b, h) do { _Pragma("unroll") for (int m = 0; m < 4; ++m) _Pragma("unroll") for (int k = 0; k < 2; ++k) dst[m][k] = *(const LAS bf16x8*)(lds + PG8_SA(b, h) + aoff + m * 2048 + k * 1024); } while (0)
#define PG8_LDB(dst, b, h) do { _Pragma("unroll") for (int n = 0; n < 2; ++n) _Pragma("unroll") for (int k = 0; k < 2; ++k) dst[n][k] = *(const LAS bf16x8*)(lds + PG8_SB(b, h) + boff + n * 2048 + k * 1024); } while (0)
#define PG8_MMA(ai, bj, At, Bt) do { __builtin_amdgcn_s_setprio(1); _Pragma("unroll") for (int m = 0; m < 4; ++m) _Pragma("unroll") for (int n = 0; n < 2; ++n) _Pragma("unroll") for (int k = 0; k < 2; ++k) \
        acc[ai][bj][m][n] = __builtin_amdgcn_mfma_f32_16x16x32_bf16(Bt[n][k], At[m][k], acc[ai][bj][m][n], 0, 0, 0); __builtin_amdgcn_s_setprio(0); } while (0)
#define PG8_WAIT_V(n) asm volatile("s_waitcnt vmcnt(" #n ")" ::: "memory")
#define PG8_WAIT_L(n) asm volatile("s_waitcnt lgkmcnt(" #n ")" ::: "memory")
#define PG8_BAR __builtin_amdgcn_s_barrier()
#define PG8_SCHED __builtin_amdgcn_sched_barrier(0)
    Unit cur, nxt; int ui = 0;
    if (!S.next(0, cur)) return;
    f32x4 acc[2][2][4][2];
#pragma unroll
    for (int a = 0; a < 2; ++a)
#pragma unroll
        for (int b = 0; b < 2; ++b)
#pragma unroll
            for (int m = 0; m < 4; ++m)
#pragma unroll
                for (int n = 0; n < 2; ++n) acc[a][b][m][n] = (f32x4){0.f, 0.f, 0.f, 0.f};
    bf16x8 At[4][2], B0[2][2], B1[2][2];
    const char* cA = (const char*)g.A + (size_t)cur.pm * tstep; const char* cB = (const char*)g.Bt + (size_t)cur.pn * tstep;
    S.a_ready(cur);
    if constexpr (SP2) {
        PG8_STAGE(PG8_SB(0, 0), cB, voffB); PG8_STAGE(PG8_SB(0, 1), cB + hstep, voffB); PG8_STAGE(PG8_SA(0, 0), cA, voffA); PG8_STAGE(PG8_SA(0, 1), cA + hstep, voffA);
        if (wr == 1) PG8_BAR;
        PG8_WAIT_V(2); PG8_BAR;
        PG8_STAGE(PG8_SB(1, 0), cB + kstep, voffB); PG8_STAGE(PG8_SA(1, 0), cA + kstep, voffA); PG8_STAGE(PG8_SB(1, 1), cB + hstep + kstep, voffB);
        PG8_WAIT_V(6); PG8_BAR;
    } else {
        PG8_STAGE(PG8_SB(0, 0), cB, voffB); PG8_STAGE(PG8_SA(0, 0), cA, voffA); PG8_STAGE(PG8_SB(0, 1), cB + hstep, voffB); PG8_STAGE(PG8_SA(0, 1), cA + hstep, voffA);
        if (wr == 1) PG8_BAR;
        PG8_WAIT_V(4); PG8_BAR;
        PG8_STAGE(PG8_SB(1, 0), cB + kstep, voffB); PG8_STAGE(PG8_SA(1, 0), cA + kstep, voffA); PG8_STAGE(PG8_SB(1, 1), cB + hstep + kstep, voffB);
        PG8_WAIT_V(6); PG8_BAR;
    }
    for (;;) {
        const bool has_next = S.next(ui + 1, nxt);
        const char* nA = has_next ? (const char*)g.A + (size_t)nxt.pm * tstep : cA; const char* nB = has_next ? (const char*)g.Bt + (size_t)nxt.pn * tstep : cB;
        for (int t = 0; t < nt; t += 2) {
            const bool last = (t == nt - 2);
            const char* a1 = cA + (size_t)(t + 1) * kstep;
            const char* a2 = last ? nA : cA + (size_t)(t + 2) * kstep; const char* b2 = last ? nB : cB + (size_t)(t + 2) * kstep;
            const char* a3 = a2 + kstep; const char* b3 = b2 + kstep;
            if (last && has_next) S.a_ready(nxt);
            if constexpr (SP2) {
            PG8_LDB(B0, 0, 0); PG8_LDB(B1, 0, 1); PG8_SCHED; PG8_LDA(At, 0, 0); PG8_STAGE(PG8_SA(1, 1), a1 + hstep, voffA);
            PG8_WAIT_V(8); PG8_WAIT_L(0); PG8_BAR; PG8_MMA(0, 0, At, B0); PG8_MMA(0, 1, At, B1); PG8_BAR; PG8_SCHED;
            PG8_LDA(At, 0, 1); PG8_STAGE(PG8_SB(0, 0), b2, voffB); PG8_STAGE(PG8_SB(0, 1), b2 + hstep, voffB); PG8_STAGE(PG8_SA(0, 0), a2, voffA);
            PG8_WAIT_V(8); PG8_WAIT_L(0); PG8_BAR; PG8_MMA(1, 0, At, B0); PG8_MMA(1, 1, At, B1); PG8_BAR; PG8_SCHED;
            PG8_LDB(B0, 1, 0); PG8_LDB(B1, 1, 1); PG8_SCHED; PG8_LDA(At, 1, 0); PG8_STAGE(PG8_SA(0, 1), a2 + hstep, voffA);
            PG8_WAIT_V(8); PG8_WAIT_L(0); PG8_BAR; PG8_MMA(0, 0, At, B0); PG8_MMA(0, 1, At, B1); PG8_BAR; PG8_SCHED;
            PG8_LDA(At, 1, 1); PG8_STAGE(PG8_SB(1, 0), b3, voffB); PG8_STAGE(PG8_SB(1, 1), b3 + hstep, voffB); PG8_STAGE(PG8_SA(1, 0), a3, voffA);
            PG8_WAIT_V(8); PG8_WAIT_L(0); PG8_BAR; PG8_MMA(1, 0, At, B0); PG8_MMA(1, 1, At, B1); PG8_BAR; PG8_SCHED;
            } else {
            PG8_LDB(B0, 0, 0); PG8_SCHED; PG8_LDA(At, 0, 0); PG8_STAGE(PG8_SA(1, 1), a1 + hstep, voffA);
            PG8_WAIT_L(8); PG8_BAR; PG8_WAIT_L(0); PG8_MMA(0, 0, At, B0); PG8_BAR; PG8_SCHED;
            PG8_LDB(B1, 0, 1); PG8_STAGE(PG8_SB(0, 0), b2, voffB);
            PG8_BAR; PG8_WAIT_L(0); PG8_MMA(0, 1, At, B1); PG8_BAR;
            PG8_LDA(At, 0, 1); PG8_STAGE(PG8_SA(0, 0), a2, voffA);
            PG8_BAR; PG8_WAIT_L(0); PG8_MMA(1, 0, At, B0); PG8_BAR; PG8_SCHED;
            PG8_STAGE(PG8_SB(0, 1), b2 + hstep, voffB);
            PG8_WAIT_V(6); PG8_BAR; PG8_MMA(1, 1, At, B1); PG8_BAR;
            PG8_LDB(B0, 1, 0); PG8_SCHED; PG8_LDA(At, 1, 0); PG8_STAGE(PG8_SA(0, 1), a2 + hstep, voffA);
            PG8_WAIT_L(8); PG8_BAR; PG8_WAIT_L(0); PG8_MMA(0, 0, At, B0); PG8_BAR; PG8_SCHED;
            PG8_LDB(B1, 1, 1); PG8_STAGE(PG8_SB(1, 0), b3, voffB);
            PG8_BAR; PG8_WAIT_L(0); PG8_MMA(0, 1, At, B1); PG8_BAR;
            PG8_LDA(At, 1, 1); PG8_STAGE(PG8_SA(1, 0), a3, voffA);
            PG8_BAR; PG8_WAIT_L(0); PG8_MMA(1, 0, At, B0); PG8_BAR; PG8_SCHED;
            PG8_STAGE(PG8_SB(1, 1), b3 + hstep, voffB);
            PG8_WAIT_V(6); PG8_BAR; PG8_MMA(1, 1, At, B1); PG8_BAR;
            }
        }
        if constexpr (ALIGN_EPI) { if (wr == 0) PG8_BAR; }
        if constexpr (!Epi::AFTER_DRAIN) { E(acc, cur, wr, wc, fr, fq); S.done(cur); }
        if (!has_next) break;
#pragma unroll
        for (int a = 0; a < 2; ++a)
#pragma unroll
            for (int b = 0; b < 2; ++b)
#pragma unroll
                for (int m = 0; m < 4; ++m)
#pragma unroll
                    for (int n = 0; n < 2; ++n) acc[a][b][m][n] = (f32x4){0.f, 0.f, 0.f, 0.f};
        cur = nxt; cA = nA; cB = nB; ++ui;
        if constexpr (ALIGN_EPI) { if (wr == 1) PG8_BAR; }
    }
    PG8_WAIT_V(0);
    if constexpr (!ALIGN_EPI) { if (wr == 0) PG8_BAR; }
    PG8_BAR;
    if constexpr (Epi::AFTER_DRAIN) { E.fused(acc, cur, wr, wc, fr, fq, lds, wid, lane); S.done(cur); }
#undef PG8_SA
#undef PG8_SB
#undef PG8_STAGE
#undef PG8_LDA
#undef PG8_LDB
#undef PG8_MMA
#undef PG8_WAIT_V
#undef PG8_WAIT_L
#undef PG8_BAR
#undef PG8_SCHED
}
}

struct Args {
    const float *x_prompt, *x_sample, *st_wkv, *st_shift, *cache_k, *cache_v, *p_prompt, *p_sample, *g_norm, *w_in, *mu, *w0, *w2, *a0, *a2,
                *k_k, *k_a, *r_k, *ln_w, *ln_b, *sinks, *w_out, *g_ple, *w_pg, *w_pp, *g_final;
    float* out; unsigned char* ws;
};

__device__ __forceinline__ void p0_transpose_item(const float* W, int K, int N, bf16_t* WT, const float* kscale, LAS float* scr, int item, int lane) {
    const int nblk = N / 32, kb = item / nblk, nb = item % nblk, k0 = 64 * kb, n0 = 32 * nb;
    float wv[32];
#pragma unroll
    for (int i = 0; i < 32; ++i) { const int kk = 2 * i + (lane >> 5); wv[i] = W[(size_t)(k0 + kk) * N + n0 + (lane & 31)]; }
#pragma unroll
    for (int i = 0; i < 32; ++i) { const int kk = 2 * i + (lane >> 5); float v = wv[i]; if (kscale) v *= kscale[k0 + kk]; scr[kk * 33 + (lane & 31)] = v; }
    LDS_WAIT();
    const int c = lane & 7;
#pragma unroll
    for (int j = 0; j < 4; ++j) { const int n = (lane >> 3) + 8 * j; const LAS float* s = scr + (8 * c) * 33 + n;
        u32x4 o; o.x = pk2(s[0 * 33], s[1 * 33]); o.y = pk2(s[2 * 33], s[3 * 33]); o.z = pk2(s[4 * 33], s[5 * 33]); o.w = pk2(s[6 * 33], s[7 * 33]);
        *(u32x4*)(WT + (size_t)(n0 + n) * K + k0 + 8 * c) = o; }
    LDS_WAIT();
}

__device__ __forceinline__ void p0_prologue(const Args& A, LAS unsigned char* lds, int tid, int lane, int wave) {
    unsigned char* ws = A.ws;
    LAS float* scr = (LAS float*)(lds + wave * 16384);
    const int gw = blockIdx.x * 8 + wave, NGW = gridDim.x * 8;
    bf16_t* Win_t = (bf16_t*)(ws + WS_WIN); bf16_t* Wout_t = (bf16_t*)(ws + WS_WOUT); bf16_t* Wpg_t = (bf16_t*)(ws + WS_WPG); bf16_t* Wpp_t = (bf16_t*)(ws + WS_WPP);
    constexpr int I_IN = 16 * (IN_DIM / 32), I_O = 16 * 32, I_PG = 16 * 32, I_PP = 4 * 32, NITEMS = I_IN + I_O + I_PG + I_PP;
    for (int it = gw; it < NITEMS; it += NGW) {
        int r = it;
        if (r < I_IN) { p0_transpose_item(A.w_in, DM, IN_DIM, Win_t, nullptr, scr, r, lane); continue; } r -= I_IN;
        if (r < I_O) { p0_transpose_item(A.w_out, DM, DM, Wout_t, nullptr, scr, r, lane); continue; } r -= I_O;
        if (r < I_PG) { p0_transpose_item(A.w_pg, DM, DM, Wpg_t, A.g_ple, scr, r, lane); continue; } r -= I_PG;
        p0_transpose_item(A.w_pp, PLE, DM, Wpp_t, nullptr, scr, r, lane);
    }
    { unsigned* ctl = (unsigned*)(ws + WS_CTL); const int gt = blockIdx.x * 512 + tid, NT = gridDim.x * 512;
      for (int i = gt; i < CW_SS3 + MTOT; i += NT) ctl[i] = 0u; }
    { const int gt = blockIdx.x * 512 + tid, NT = gridDim.x * 512; u32x4* zp = (u32x4*)(Win_t + (size_t)IN_DIM * DM);
      for (int i = gt; i < (NZ - IN_DIM) * DM / 8; i += NT) zp[i] = (u32x4){0u, 0u, 0u, 0u}; }
    { const int gt = blockIdx.x * 512 + tid, NT = gridDim.x * 512; float* ct = (float*)(ws + WS_ROPE); float* st = ct + 2056 * 8;
      for (int i = gt; i < 2056 * 8; i += NT) { const int pi = i >> 3, fi = i & 7; const int pos = pi < 2048 ? pi : 16384 + pi - 2048;
          const float inv = fi == 0 ? 1.0f : fi == 1 ? 0.19392274f : fi == 2 ? 0.03760603f : fi == 3 ? 0.0072926646f : fi == 4 ? 0.0014142136f : fi == 5 ? 0.0002742482f : fi == 6 ? 5.3182957e-05f : 1.0313385e-05f;
          const float angf = (float)pos * inv; const double ang = (double)angf; const double n = __builtin_rint(ang * 0.15915494309189535); const double r = __builtin_fma(-n, 6.283185307179586, ang);
          const float rf = (float)r; ct[i] = cosf(rf); st[i] = sinf(rf); } }
    { const int gt = blockIdx.x * 512 + tid, NT = gridDim.x * 512; bf16_t* W2T = (bf16_t*)(ws + WS_W2T); bf16_t* A2T = (bf16_t*)(ws + WS_A2T);
      for (int i = gt; i < 512 * 64; i += NT) { const int cc = i >> 6, j = i & 63; W2T[i] = (bf16_t)f2bf(A.w2[j * 512 + cc]); A2T[i] = (bf16_t)f2bf(A.a2[j * 512 + cc]); } }
    bf16_t* XN = (bf16_t*)(ws + WS_XN); bf16_t* PB = (bf16_t*)(ws + WS_PB);
    f32x4 gv[4];
#pragma unroll
    for (int j = 0; j < 4; ++j) gv[j] = *((const f32x4*)A.g_norm + lane + 64 * j);
    {
        f32x4 v[4], nv[4]; f32x4 pv, npv;
        int m = gw;
        if (m < MTOT) { const float* xrow = m < MP ? A.x_prompt + (size_t)m * DM : A.x_sample + (size_t)(m - MP) * DM; const float* prow = m < MP ? A.p_prompt + (size_t)m * PLE : A.p_sample + (size_t)(m - MP) * PLE;
#pragma unroll
            for (int j = 0; j < 4; ++j) v[j] = *((const f32x4*)xrow + lane + 64 * j);
            pv = *((const f32x4*)prow + lane); }
        for (; m < MTOT; m += NGW) {
            const int mn = m + NGW;
            if (mn < MTOT) { const float* xrow = mn < MP ? A.x_prompt + (size_t)mn * DM : A.x_sample + (size_t)(mn - MP) * DM; const float* prow = mn < MP ? A.p_prompt + (size_t)mn * PLE : A.p_sample + (size_t)(mn - MP) * PLE;
#pragma unroll
                for (int j = 0; j < 4; ++j) nv[j] = *((const f32x4*)xrow + lane + 64 * j);
                npv = *((const f32x4*)prow + lane); }
            float s = 0.f;
#pragma unroll
            for (int j = 0; j < 4; ++j) s += (v[j].x * v[j].x + v[j].y * v[j].y) + (v[j].z * v[j].z + v[j].w * v[j].w);
            const float rstd = __builtin_amdgcn_rsqf(wave_sum(s) * (1.f / DM) + NORM_EPS);
            u32x2* o8 = (u32x2*)(XN + (size_t)m * DM) + lane;
#pragma unroll
            for (int j = 0; j < 4; ++j) { u32x2 o; o.x = pk2(v[j].x * rstd * gv[j].x, v[j].y * rstd * gv[j].y); o.y = pk2(v[j].z * rstd * gv[j].z, v[j].w * rstd * gv[j].w); o8[64 * j] = o; }
            u32x2 po; po.x = pk2(pv.x, pv.y); po.y = pk2(pv.z, pv.w);
            *((u32x2*)(PB + (size_t)m * PLE) + lane) = po;
#pragma unroll
            for (int j = 0; j < 4; ++j) v[j] = nv[j];
            pv = npv;
        }
    }
}

constexpr int SC_ZS = 0, SC_OP = 40960, SC_Y = 81920, SC_C = 90112;
__device__ __forceinline__ void sscan_item(const Args& A, LAS unsigned char* lds, int tid, int lane, int wave, int bg, int h) {
    const bf16_t* Z = (const bf16_t*)(A.ws + WS_Z); bf16_t* MIX = (bf16_t*)(A.ws + WS_XN);
    LAS float* ZS = (LAS float*)(lds + SC_ZS); LAS float* OP = (LAS float*)(lds + SC_OP); LAS float* YB = (LAS float*)(lds + SC_Y); LAS float* CB = (LAS float*)(lds + SC_C);
    const int fr = lane & 15, q4 = lane >> 4;
    const int mt = wave & 1, nt = wave >> 1, cl = nt * 16 + fr, cg_ = h * 64 + cl;
    bf16x8 bw[2], ba[2];
#pragma unroll
    for (int ks = 0; ks < 2; ++ks) { bw[ks] = *(const bf16x8*)((const bf16_t*)(A.ws + WS_W2T) + cg_ * 64 + ks * 32 + q4 * 8); ba[ks] = *(const bf16x8*)((const bf16_t*)(A.ws + WS_A2T) + cg_ * 64 + ks * 32 + q4 * 8); }
    const float w0c = A.w0[cg_], a0c = A.a0[cg_], kkc = A.k_k[cg_], kac = A.k_a[cg_];
    const float rkl = A.r_k[h * 64 + lane], lnw = A.ln_w[h * 64 + lane], lnb = A.ln_b[h * 64 + lane];
    const int vr = (tid >> 3) & 31, kq = tid & 7;
    f32x4 s0pre[2][4];
#pragma unroll
    for (int rep = 0; rep < 2; ++rep) { const int b_ = bg * 4 + (tid >> 8) + 2 * rep; const float* S0_ = A.st_wkv + ((size_t)b_ * 8 + h) * 4096;
        s0pre[rep][0] = *(const f32x4*)(S0_ + vr * 64 + kq * 8); s0pre[rep][1] = *(const f32x4*)(S0_ + vr * 64 + kq * 8 + 4);
        s0pre[rep][2] = *(const f32x4*)(S0_ + (vr + 32) * 64 + kq * 8); s0pre[rep][3] = *(const f32x4*)(S0_ + (vr + 32) * 64 + kq * 8 + 4); }
    {
        for (int idx = tid; idx < 32 * 40; idx += 512) {
            const int t = idx / 40, cc = idx % 40, s = cc >> 3, within = (cc & 7) * 8;
            float o[8];
            {
                const int bi = t >> 3, tt = t & 7, b = bg * 4 + bi; const float* shift0 = A.st_shift + (size_t)b * SHIFT;
                const int zcol = (s == 0 ? h * 64 : s == 1 ? 512 + h * 64 : s == 2 ? 1024 + h * 64 : s == 3 ? 1536 : 1600) + within;
                const size_t row = (size_t)MP + (size_t)b * 8 + tt;
                float cur[8], prv[8]; unpack8(*(const u32x4*)(Z + row * NZ + zcol), cur);
                if (tt == 0) {
                    { const f32x4 p0 = *(const f32x4*)(shift0 + zcol), p1 = *(const f32x4*)(shift0 + zcol + 4);
                        prv[0] = p0.x; prv[1] = p0.y; prv[2] = p0.z; prv[3] = p0.w; prv[4] = p1.x; prv[5] = p1.y; prv[6] = p1.z; prv[7] = p1.w; }
                } else unpack8(*(const u32x4*)(Z + (row - 1) * NZ + zcol), prv);
                const f32x4 m0 = *(const f32x4*)(A.mu + zcol), m1 = *(const f32x4*)(A.mu + zcol + 4);
                const float mu[8] = {m0.x, m0.y, m0.z, m0.w, m1.x, m1.y, m1.z, m1.w};
#pragma unroll
                for (int i = 0; i < 8; ++i) { float v = cur[i] + mu[i] * (prv[i] - cur[i]); if (s == 3) v = tanhf(v); o[i] = v; }
            }
            LAS f32x4* dst = (LAS f32x4*)(ZS + t * 320 + s * 64 + within);
            dst[0] = (f32x4){o[0], o[1], o[2], o[3]}; dst[1] = (f32x4){o[4], o[5], o[6], o[7]};
        }
        __syncthreads();
        {
            f32x4 accw = {0.f, 0.f, 0.f, 0.f}, acca = {0.f, 0.f, 0.f, 0.f};
#pragma unroll
            for (int ks = 0; ks < 2; ++ks) {
                const LAS f32x4* pt = (const LAS f32x4*)(ZS + (mt * 16 + fr) * 320 + 192 + ks * 32 + q4 * 8);
                const LAS f32x4* pa = (const LAS f32x4*)(ZS + (mt * 16 + fr) * 320 + 256 + ks * 32 + q4 * 8);
                const f32x4 t0v = pt[0], t1v = pt[1], a0v = pa[0], a1v = pa[1];
                u32x4 tw; tw.x = pk2(t0v.x, t0v.y); tw.y = pk2(t0v.z, t0v.w); tw.z = pk2(t1v.x, t1v.y); tw.w = pk2(t1v.z, t1v.w);
                u32x4 aw; aw.x = pk2(a0v.x, a0v.y); aw.y = pk2(a0v.z, a0v.w); aw.z = pk2(a1v.x, a1v.y); aw.w = pk2(a1v.z, a1v.w);
                accw = __builtin_amdgcn_mfma_f32_16x16x32_bf16(__builtin_bit_cast(bf16x8, tw), bw[ks], accw, 0, 0, 0);
                acca = __builtin_amdgcn_mfma_f32_16x16x32_bf16(__builtin_bit_cast(bf16x8, aw), ba[ks], acca, 0, 0, 0);
            }
#pragma unroll
            for (int j = 0; j < 4; ++j) {
                const int t = mt * 16 + q4 * 4 + j;
                const float xw = w0c + accw[j];
                const float dec = __expf(-0.6065306597126334f * sigmoidf_(xw));
                const float av = sigmoidf_(a0c + acca[j]);
                const float kx = ZS[t * 320 + 64 + cl], rr = ZS[t * 320 + cl];
                OP[t * 320 + cl] = kx * kkc; OP[t * 320 + 64 + cl] = rr * dec; OP[t * 320 + 128 + cl] = dec; OP[t * 320 + 192 + cl] = av;
                OP[t * 320 + 256 + cl] = kx * (1.f + (av - 1.f) * kac);
            }
        }
        __syncthreads();
#pragma unroll
        for (int i = 0; i < 4; ++i) {
            const int t = wave * 4 + i;
            const float kr = OP[t * 320 + lane], av = OP[t * 320 + 192 + lane], kv = OP[t * 320 + 256 + lane], rr = ZS[t * 320 + lane];
            const float n2 = wave_sum(kr * kr); const float inv = 1.f / fmaxf(sqrtf(n2), 1e-12f);
            const float kk = kr * inv, bb = kk * av;
            const float c1 = wave_sum(bb * rr), c2 = wave_sum(kv * rr), bc = wave_sum(rr * kv * rkl);
            OP[t * 320 + lane] = kk; OP[t * 320 + 192 + lane] = bb;
            if (lane == 0) { CB[t * 4 + 0] = c1; CB[t * 4 + 1] = c2; CB[t * 4 + 2] = bc; }
        }
        __syncthreads();
        {
            const int hh = tid >> 8;
#pragma unroll
            for (int rep = 0; rep < 2; ++rep) {
                const int bi = hh + 2 * rep, b = bg * 4 + bi;
                float* wkv_out = A.out + OUT_WKVS + ((size_t)b * 8 + h) * 4096;
                float s0[8], s1[8];
#pragma unroll
                for (int i = 0; i < 4; ++i) { s0[i] = s0pre[rep][0][i]; s0[4 + i] = s0pre[rep][1][i]; s1[i] = s0pre[rep][2][i]; s1[4 + i] = s0pre[rep][3][i]; }
                for (int tt = 0; tt < 8; ++tt) {
                    const int t = bi * 8 + tt;
                    const LAS f32x4* op = (const LAS f32x4*)(OP + t * 320 + kq * 8);
                    float kk[8], rw[8], ww[8], bb[8], kv[8];
                    { f32x4 a = op[0], c = op[1]; kk[0] = a.x; kk[1] = a.y; kk[2] = a.z; kk[3] = a.w; kk[4] = c.x; kk[5] = c.y; kk[6] = c.z; kk[7] = c.w; }
                    { f32x4 a = op[16], c = op[17]; rw[0] = a.x; rw[1] = a.y; rw[2] = a.z; rw[3] = a.w; rw[4] = c.x; rw[5] = c.y; rw[6] = c.z; rw[7] = c.w; }
                    { f32x4 a = op[32], c = op[33]; ww[0] = a.x; ww[1] = a.y; ww[2] = a.z; ww[3] = a.w; ww[4] = c.x; ww[5] = c.y; ww[6] = c.z; ww[7] = c.w; }
                    { f32x4 a = op[48], c = op[49]; bb[0] = a.x; bb[1] = a.y; bb[2] = a.z; bb[3] = a.w; bb[4] = c.x; bb[5] = c.y; bb[6] = c.z; bb[7] = c.w; }
                    { f32x4 a = op[64], c = op[65]; kv[0] = a.x; kv[1] = a.y; kv[2] = a.z; kv[3] = a.w; kv[4] = c.x; kv[5] = c.y; kv[6] = c.z; kv[7] = c.w; }
                    const float v0 = ZS[t * 320 + 128 + vr], v1 = ZS[t * 320 + 128 + vr + 32];
                    const float c1 = CB[t * 4 + 0], c2 = CB[t * 4 + 1];
                    float sa0 = 0.f, sa1 = 0.f, yp0 = 0.f, yp1 = 0.f;
#pragma unroll
                    for (int i = 0; i < 8; ++i) { sa0 += s0[i] * kk[i]; sa1 += s1[i] * kk[i]; yp0 += s0[i] * rw[i]; yp1 += s1[i] * rw[i]; }
                    sa0 = red8_sum(sa0); sa1 = red8_sum(sa1); yp0 = red8_sum(yp0); yp1 = red8_sum(yp1);
#pragma unroll
                    for (int i = 0; i < 8; ++i) { s0[i] = s0[i] * ww[i] - sa0 * bb[i] + v0 * kv[i]; s1[i] = s1[i] * ww[i] - sa1 * bb[i] + v1 * kv[i]; }
                    if (kq == 0) { YB[t * 64 + vr] = yp0 - sa0 * c1 + v0 * c2; YB[t * 64 + vr + 32] = yp1 - sa1 * c1 + v1 * c2; }
                }
                float* w0p = wkv_out + vr * 64 + kq * 8; float* w1p = wkv_out + (vr + 32) * 64 + kq * 8;
                *(f32x4*)w0p = (f32x4){s0[0], s0[1], s0[2], s0[3]}; *(f32x4*)(w0p + 4) = (f32x4){s0[4], s0[5], s0[6], s0[7]};
                *(f32x4*)w1p = (f32x4){s1[0], s1[1], s1[2], s1[3]}; *(f32x4*)(w1p + 4) = (f32x4){s1[4], s1[5], s1[6], s1[7]};
            }
        }
        __syncthreads();
#pragma unroll
        for (int i = 0; i < 4; ++i) {
            const int t = wave * 4 + i;
            {
                const float y = YB[t * 64 + lane];
                const float mean = wave_sum(y) * (1.f / 64.f); const float d = y - mean; const float var = wave_sum(d * d) * (1.f / 64.f);
                const float yn = d * (__builtin_amdgcn_rsqf(var + GN_EPS)) * lnw + lnb;
                const float o = yn + CB[t * 4 + 2] * ZS[t * 320 + 128 + lane];
                const size_t row = (size_t)MP + (size_t)(bg * 4 + (t >> 3)) * 8 + (t & 7);
                const float g = bf2f(Z[row * NZ + O_GR + h * 64 + lane]);
                MIX[row * DM + h * 64 + lane] = (bf16_t)f2bf(o * siluf_(g));
            }
        }
        __syncthreads();
    }
    if (h == 0) { for (int c = tid; c < 4 * SHIFT; c += 512) { const int bi = c / SHIFT, cc = c % SHIFT, b = bg * 4 + bi; const size_t row = (size_t)MP + (size_t)b * 8 + 7;
        A.out[OUT_SHS + (size_t)b * SHIFT + cc] = bf2f(Z[row * NZ + cc]); } }
}
constexpr int CA_ZR = 0, CA_ZK = 16384, CA_ZV = 32768, CA_TH = 49152, CA_AD = 58368, CA_LW = 67584, CA_AA = 83968, CA_SEG = 100352, CA_G = 102400;
constexpr int CA_KKT = 0, CA_BT = 9216, CA_KT = 18432, CA_RT = 27648, CA_NBHT = 36864, CA_KHT = 46080, CA_VT = 55296, CA_RHS = 64512, CA_XT = 0,
              CA_N = 102656, CA_MAK = 119040, CA_NMRB = 128256, CA_MRK = 137472;

__device__ __forceinline__ float wsum_fast(float x) {
    x += dppf<0xB1>(x); x += dppf<0x4E>(x); x += dppf<0x141>(x); x += dppf<0x140>(x);
    const int xi = __builtin_bit_cast(int, x);
    return __builtin_bit_cast(float, __builtin_amdgcn_readlane(xi, 0)) + __builtin_bit_cast(float, __builtin_amdgcn_readlane(xi, 16)) +
           __builtin_bit_cast(float, __builtin_amdgcn_readlane(xi, 32)) + __builtin_bit_cast(float, __builtin_amdgcn_readlane(xi, 48));
}
__device__ __forceinline__ bf16x8 ldsfrag(const LAS unsigned char* base, int row, int kofs) { return *(const LAS bf16x8*)(base + row * 144 + kofs * 2); }
__device__ __forceinline__ u32x2 pack4(float a, float b, float c, float d) { u32x2 o; o.x = pk2(a, b); o.y = pk2(c, d); return o; }
#define MFMA16(a, b, c) __builtin_amdgcn_mfma_f32_16x16x32_bf16(a, b, c, 0, 0, 0)


struct HeadConstA { int h; bf16x8 bw[2][2], ba[2][2]; float w0c[2], a0c[2], kkc, kac, rkc; };
__device__ __forceinline__ void load_headconst(const Args& A, HeadConstA& H, int h, int tid, int lane, int wave) {
    const int fr = lane & 15, q4 = lane >> 4, nth = wave >> 2;
    const bf16_t* W2T = (const bf16_t*)(A.ws + WS_W2T); const bf16_t* A2T = (const bf16_t*)(A.ws + WS_A2T);
#pragma unroll
    for (int nn = 0; nn < 2; ++nn) { const int cgl = h * 64 + (nth * 2 + nn) * 16 + fr;
#pragma unroll
        for (int ks = 0; ks < 2; ++ks) { H.bw[nn][ks] = *(const bf16x8*)(W2T + cgl * 64 + ks * 32 + q4 * 8); H.ba[nn][ks] = *(const bf16x8*)(A2T + cgl * 64 + ks * 32 + q4 * 8); }
        H.w0c[nn] = A.w0[cgl]; H.a0c[nn] = A.a0[cgl]; }
    { const int cgl = h * 64 + lane; H.kkc = A.k_k[cgl]; H.kac = A.k_a[cgl]; H.rkc = A.r_k[cgl]; }
    H.h = h;
}

__device__ __forceinline__ void chunkA_item(const Args& A, LAS unsigned char* lds, int tid, int lane, int wave, int ci, int ci_next, HeadConstA& H) {
    const int c = ci & 31, h = (ci >> 5) & 7, b = ci >> 8;
    if (h != H.h) load_headconst(A, H, h, tid, lane, wave);
    const bf16_t* Z = (const bf16_t*)(A.ws + WS_Z);
    const size_t row0 = (size_t)b * SEQ + c * 64;
    const int fr = lane & 15, q4 = lane >> 4;
    {
        const int t = tid >> 3, part = tid & 7; const bool first = (c == 0 && t == 0);
        const bf16_t* zr = Z + (row0 + t) * NZ; const bf16_t* zp = zr - NZ;
#pragma unroll
        for (int s = 0; s < 5; ++s) {
            const int zcol = (s == 0 ? h * 64 : s == 1 ? 512 + h * 64 : s == 2 ? 1024 + h * 64 : s == 3 ? 1536 : 1600) + part * 8;
            const u32x4 cu = *(const u32x4*)(zr + zcol); u32x4 pu = {0u, 0u, 0u, 0u}; if (!first) pu = *(const u32x4*)(zp + zcol);
            const f32x4 m0 = *(const f32x4*)(A.mu + zcol), m1 = *(const f32x4*)(A.mu + zcol + 4);
            float cur[8], prv[8], o[8]; unpack8(cu, cur); unpack8(pu, prv);
            const float mu[8] = {m0.x, m0.y, m0.z, m0.w, m1.x, m1.y, m1.z, m1.w};
#pragma unroll
            for (int i = 0; i < 8; ++i) o[i] = cur[i] + mu[i] * (prv[i] - cur[i]);
            if (s < 3) { LAS f32x4* dst = (LAS f32x4*)(lds + s * 16384 + (t * 64 + part * 8) * 4); dst[0] = (f32x4){o[0], o[1], o[2], o[3]}; dst[1] = (f32x4){o[4], o[5], o[6], o[7]}; }
            else { if (s == 3) {
#pragma unroll
                    for (int i = 0; i < 8; ++i) o[i] = 1.f - 2.f * __builtin_amdgcn_rcpf(1.f + __expf(2.f * o[i])); }
                *(LAS u32x4*)(lds + (s == 3 ? CA_TH : CA_AD) + t * 144 + part * 16) = pack8(o); }
        }
    }
    LBAR();
    {
        const int mt = wave & 3, nth = wave >> 2;
        bf16x8 ath[2], aad[2];
#pragma unroll
        for (int ks = 0; ks < 2; ++ks) { ath[ks] = ldsfrag(lds + CA_TH, mt * 16 + fr, ks * 32 + q4 * 8); aad[ks] = ldsfrag(lds + CA_AD, mt * 16 + fr, ks * 32 + q4 * 8); }
#pragma unroll
        for (int nn = 0; nn < 2; ++nn) {
            const int cl = (nth * 2 + nn) * 16 + fr;
            f32x4 accw = {0.f, 0.f, 0.f, 0.f}, acca = {0.f, 0.f, 0.f, 0.f};
#pragma unroll
            for (int ks = 0; ks < 2; ++ks) { accw = MFMA16(ath[ks], H.bw[nn][ks], accw); acca = MFMA16(aad[ks], H.ba[nn][ks], acca); }
            const float w0c = H.w0c[nn], a0c = H.a0c[nn];
#pragma unroll
            for (int jj = 0; jj < 4; ++jj) { const int t = mt * 16 + q4 * 4 + jj;
                ((LAS float*)(lds + CA_LW))[t * 64 + cl] = -0.6065306597126334f * sigmoidf_(w0c + accw[jj]);
                ((LAS float*)(lds + CA_AA))[t * 64 + cl] = sigmoidf_(a0c + acca[jj]); }
        }
    }
    LBAR();
    {
        const int cc = lane, seg = wave;
        float lwv[8], pre[8], zr[8], zk[8], zv[8], av[8];
#pragma unroll
        for (int i = 0; i < 8; ++i) { const int t = seg * 8 + i; lwv[i] = ((LAS float*)(lds + CA_LW))[t * 64 + cc]; zr[i] = ((LAS float*)(lds + CA_ZR))[t * 64 + cc];
            zk[i] = ((LAS float*)(lds + CA_ZK))[t * 64 + cc]; zv[i] = ((LAS float*)(lds + CA_ZV))[t * 64 + cc]; av[i] = ((LAS float*)(lds + CA_AA))[t * 64 + cc]; }
        pre[0] = lwv[0];
#pragma unroll
        for (int i = 1; i < 8; ++i) pre[i] = pre[i - 1] + lwv[i];
        ((LAS float*)(lds + CA_SEG))[seg * 64 + cc] = pre[7];
        LBAR();
        float off = 0.f, tot = 0.f;
#pragma unroll
        for (int s = 0; s < 8; ++s) { const float v = ((LAS float*)(lds + CA_SEG))[s * 64 + cc]; tot += v; if (s < seg) off += v; }
        const float kkc = H.kkc, kac = H.kac, rkc = H.rkc;
        float rhs8[8], nbh8[8], kh8[8];
        float* BCg = (float*)(A.ws + WS_BC) + (size_t)ci * 64;
#pragma unroll
        for (int i = 0; i < 8; ++i) { const int t = seg * 8 + i;
            const float lg = off + pre[i], lgp = lg - lwv[i];
            const float kkraw = zk[i] * kkc; const float n2 = wsum_fast(kkraw * kkraw); const float kk = kkraw * __builtin_amdgcn_rsqf(fmaxf(n2, 1e-24f));
            const float a = av[i], bb = kk * a, km = zk[i] * (1.f + (a - 1.f) * kac);
            const float bc = wsum_fast(zr[i] * km * rkc); if (lane == 0) BCg[t] = bc;
            const float e_in = __expf(lg), e_pr = __expf(lgp), e_out = __expf(-lg), e_h = __expf(tot - lg);
            const float kkt = kk * e_pr; rhs8[i] = kkt; nbh8[i] = -(bb * e_h); kh8[i] = km * e_h;
            *(LAS unsigned short*)(lds + CA_KKT + t * 144 + cc * 2) = (unsigned short)f2bf(kkt);
            *(LAS unsigned short*)(lds + CA_RT + t * 144 + cc * 2) = (unsigned short)f2bf(zr[i] * e_in);
            *(LAS unsigned short*)(lds + CA_BT + t * 144 + cc * 2) = (unsigned short)f2bf(bb * e_out);
            *(LAS unsigned short*)(lds + CA_KT + t * 144 + cc * 2) = (unsigned short)f2bf(km * e_out); }
        *(LAS u32x4*)(lds + CA_NBHT + cc * 144 + seg * 16) = pack8(nbh8); *(LAS u32x4*)(lds + CA_KHT + cc * 144 + seg * 16) = pack8(kh8); *(LAS u32x4*)(lds + CA_VT + cc * 144 + seg * 16) = pack8(zv);
        LAS f32x4* rp = (LAS f32x4*)(lds + CA_RHS + (cc * 68 + seg * 8) * 4); rp[0] = (f32x4){rhs8[0], rhs8[1], rhs8[2], rhs8[3]}; rp[1] = (f32x4){rhs8[4], rhs8[5], rhs8[6], rhs8[7]};
        if (seg == 0) ((LAS float*)(lds + CA_G))[cc] = __expf(tot);
    }
    LBAR();
    {
        const int og = wave >> 2, ms = wave & 3;
        const LAS unsigned char* Bsrc = lds + (og == 0 ? CA_KKT : CA_RT);
        bf16x8 aB[2], aK[2];
#pragma unroll
        for (int ks = 0; ks < 2; ++ks) { aB[ks] = ldsfrag(lds + CA_BT, ms * 16 + fr, ks * 32 + q4 * 8); aK[ks] = ldsfrag(lds + CA_KT, ms * 16 + fr, ks * 32 + q4 * 8); }
        LAS unsigned char* O1 = lds + (og == 0 ? CA_MAK : CA_MRK);
#pragma unroll
        for (int nt = 0; nt < 4; ++nt) {
            const int t = nt * 16 + fr, s0 = ms * 16 + q4 * 4;
            if (nt < ms) {
                *(LAS u32x2*)(O1 + t * 144 + s0 * 2) = (u32x2){0u, 0u};
                if (og == 1) *(LAS u32x2*)(lds + CA_NMRB + t * 144 + s0 * 2) = (u32x2){0u, 0u};
            } else {
                f32x4 acc1 = {0.f, 0.f, 0.f, 0.f}, acc2 = {0.f, 0.f, 0.f, 0.f};
#pragma unroll
                for (int ks = 0; ks < 2; ++ks) { const bf16x8 bb = ldsfrag(Bsrc, t, ks * 32 + q4 * 8); acc1 = MFMA16(aB[ks], bb, acc1); acc2 = MFMA16(aK[ks], bb, acc2); }
                float v1[4], v2[4];
#pragma unroll
                for (int jj = 0; jj < 4; ++jj) { const int s = s0 + jj; const bool ok = og == 0 ? (s < t) : (s <= t); v1[jj] = ok ? acc1[jj] : 0.f; v2[jj] = ok ? acc2[jj] : 0.f; }
                *(LAS u32x2*)(O1 + t * 144 + s0 * 2) = pack4(v2[0], v2[1], v2[2], v2[3]);
                if (og == 0) {
#pragma unroll
                    for (int jj = 0; jj < 4; ++jj) ((LAS float*)(lds + CA_N))[t * 64 + jj * 16 + ms * 4 + q4] = v1[jj];
                } else *(LAS u32x2*)(lds + CA_NMRB + t * 144 + s0 * 2) = pack4(-v1[0], -v1[1], -v1[2], -v1[3]);
            }
        }
    }
    LBAR();
    {
        const int mt = wave >> 1;
        bf16x8 aM[2];
#pragma unroll
        for (int ks = 0; ks < 2; ++ks) aM[ks] = ldsfrag(lds + CA_MAK, mt * 16 + fr, ks * 32 + q4 * 8);
#pragma unroll
        for (int nn = 0; nn < 2; ++nn) { const int nt = (wave & 1) * 2 + nn; f32x4 acc = {0.f, 0.f, 0.f, 0.f};
#pragma unroll
            for (int ks = 0; ks < 2; ++ks) acc = MFMA16(aM[ks], ldsfrag(lds + CA_VT, nt * 16 + fr, ks * 32 + q4 * 8), acc);
            *(LAS f32x4*)(lds + CA_RHS + ((64 + nt * 16 + fr) * 68 + mt * 16 + q4 * 4) * 4) = acc; }
    }
    LBAR();
    if (tid < 256) {
        const int cp = tid >> 2, q = tid & 3;
        f32x2_t xa[8], xb[8];
#pragma unroll
        for (int m = 0; m < 8; ++m) { xa[m] = (f32x2_t){0.f, 0.f}; xb[m] = (f32x2_t){0.f, 0.f}; }
        const LAS float* Np = (const LAS float*)(lds + CA_N) + q * 16;
        const LAS float* Ra = (const LAS float*)(lds + CA_RHS) + cp * 68; const LAS float* Rb = Ra + 64 * 68;
        float a4[4], b4[4];
#pragma unroll
        for (int t = 0; t < 64; ++t) {
            f32x2_t sa = {0.f, 0.f}, sb = {0.f, 0.f};
#pragma unroll
            for (int p = 0; p < ((t + 3) / 4 + 1) / 2; ++p) { const f32x2_t nv = *(const LAS f32x2_t*)(Np + t * 64 + 2 * p); sa += nv * xa[p]; sb += nv * xb[p]; }
            float ua = sa.x + sa.y, ub = sb.x + sb.y;
            ua += dppf<0xB1>(ua); ub += dppf<0xB1>(ub); ua += dppf<0x4E>(ua); ub += dppf<0x4E>(ub);
            const float xta = Ra[t] - ua, xtb = Rb[t] - ub;
            if (q == (t & 3)) { if ((t >> 2) & 1) { xa[t >> 3].y = xta; xb[t >> 3].y = xtb; } else { xa[t >> 3].x = xta; xb[t >> 3].x = xtb; } }
            a4[t & 3] = xta; b4[t & 3] = xtb;
            if ((t & 3) == 3 && q == 0) { *(LAS u32x2*)(lds + CA_XT + cp * 144 + (t - 3) * 2) = pack4(a4[0], a4[1], a4[2], a4[3]);
                *(LAS u32x2*)(lds + CA_XT + (64 + cp) * 144 + (t - 3) * 2) = pack4(b4[0], b4[1], b4[2], b4[3]); }
        }
    } else if (ci_next < 4096) {
        const int cn = ci_next & 31, hn = (ci_next >> 5) & 7, bn = ci_next >> 8; const long rown = (long)bn * SEQ + cn * 64 - 1;
        for (int l = tid - 256; l < 65 * 5; l += 256) { const int r = l / 5, sec = l % 5; long rr = rown + r; if (rr < 0) rr = 0;
            const bf16_t* p = Z + rr * NZ + (sec == 0 ? hn * 64 : sec == 1 ? 512 + hn * 64 : sec == 2 ? 1024 + hn * 64 : sec == 3 ? 1536 : 1600);
            unsigned dummy; asm volatile("global_load_dword %0, %1, off" : "=v"(dummy) : "v"(p) : "memory"); }
        asm volatile("s_waitcnt vmcnt(0)" ::: "memory");
    }
    LBAR();
    {
        const int mt = wave >> 1;
        unsigned char* pq = (unsigned char*)A.out + CH_PQ + (size_t)ci * 24576; bf16_t* PTg = (bf16_t*)pq; float* Qg = (float*)(pq + 8192);
        bf16_t* RHg = (bf16_t*)(A.ws + WS_RY + (size_t)ci * 16384); bf16_t* Y0g = RHg + 4096;
        bf16x8 aX[2], aV[2], aS[2];
#pragma unroll
        for (int ks = 0; ks < 2; ++ks) { aX[ks] = ldsfrag(lds + CA_XT, mt * 16 + fr, ks * 32 + q4 * 8); aV[ks] = ldsfrag(lds + CA_VT, mt * 16 + fr, ks * 32 + q4 * 8);
            aS[ks] = ldsfrag(lds + CA_XT, 64 + mt * 16 + fr, ks * 32 + q4 * 8); }
#pragma unroll
        for (int nn = 0; nn < 2; ++nn) { const int nt = (wave & 1) * 2 + nn, rn = nt * 16 + fr, r0 = mt * 16 + q4 * 4;
            bf16x8 bN[2], bK[2], bMb[2], bMk[2];
#pragma unroll
            for (int ks = 0; ks < 2; ++ks) { bN[ks] = ldsfrag(lds + CA_NBHT, rn, ks * 32 + q4 * 8); bK[ks] = ldsfrag(lds + CA_KHT, rn, ks * 32 + q4 * 8);
                bMb[ks] = ldsfrag(lds + CA_NMRB, rn, ks * 32 + q4 * 8); bMk[ks] = ldsfrag(lds + CA_MRK, rn, ks * 32 + q4 * 8); }
            f32x4 aP = {0.f, 0.f, 0.f, 0.f}, aQ = {0.f, 0.f, 0.f, 0.f}, aR = {0.f, 0.f, 0.f, 0.f}, aY = {0.f, 0.f, 0.f, 0.f};
#pragma unroll
            for (int ks = 0; ks < 2; ++ks) { aP = MFMA16(aX[ks], bN[ks], aP); aQ = MFMA16(aV[ks], bK[ks], aQ); aQ = MFMA16(aS[ks], bN[ks], aQ);
                aR = MFMA16(aX[ks], bMb[ks], aR); aY = MFMA16(aV[ks], bMk[ks], aY); aY = MFMA16(aS[ks], bMb[ks], aY); }
            const float gj = ((LAS float*)(lds + CA_G))[rn];
            *(u32x2*)(PTg + rn * 64 + r0) = pack4(aP[0] + (r0 + 0 == rn ? gj : 0.f), aP[1] + (r0 + 1 == rn ? gj : 0.f), aP[2] + (r0 + 2 == rn ? gj : 0.f), aP[3] + (r0 + 3 == rn ? gj : 0.f));
#pragma unroll
            for (int jj = 0; jj < 4; ++jj) Qg[(r0 + jj) * 64 + rn] = aQ[jj];
            { const u32x2 rt = *(const LAS u32x2*)(lds + CA_RT + rn * 144 + r0 * 2);
              *(u32x2*)(RHg + rn * 64 + r0) = pack4(bflo(rt.x) + aR[0], bfhi(rt.x) + aR[1], bflo(rt.y) + aR[2], bfhi(rt.y) + aR[3]); }
            *(u32x2*)(Y0g + rn * 64 + r0) = pack4(aY[0], aY[1], aY[2], aY[3]);
        }
    }
    LBAR();
}

constexpr int CB_SH = 0, CB_SL = 9216;
__device__ __forceinline__ void chunkB_item(const Args& A, LAS unsigned char* lds, int tid, int lane, int wave, int bh) {
    const int fr = lane & 15, q4 = lane >> 4, mt = wave >> 1, nt0 = (wave & 1) * 2, v0 = mt * 16 + q4 * 4;
    const int h = bh & 7, b = bh >> 3, colg = h * 64 + v0;
    const bf16_t* Z = (const bf16_t*)(A.ws + WS_Z); bf16_t* MIX = (bf16_t*)(A.ws + WS_XN);
    LAS float* ST = (LAS float*)(lds + 18432);
    f32x4 acc[2] = {{0.f, 0.f, 0.f, 0.f}, {0.f, 0.f, 0.f, 0.f}};
#define B_LOAD(BP, QV, cc) do { const size_t ci_ = (size_t)bh * 32 + (cc); const unsigned char* pq_ = (const unsigned char*)A.out + CH_PQ + ci_ * 24576; \
        const bf16_t* PTg_ = (const bf16_t*)pq_; const float* Qg_ = (const float*)(pq_ + 8192); \
        _Pragma("unroll") for (int nn = 0; nn < 2; ++nn) { const int rn = (nt0 + nn) * 16 + fr; \
            _Pragma("unroll") for (int ks = 0; ks < 2; ++ks) BP[nn][ks] = *(const bf16x8*)(PTg_ + rn * 64 + ks * 32 + q4 * 8); \
            _Pragma("unroll") for (int jj = 0; jj < 4; ++jj) QV[nn][jj] = Qg_[(mt * 16 + q4 * 4 + jj) * 64 + rn]; } } while (0)
#define B_LOADY(bR, y0_, zc_, zp_, zg_, bc_, cc) do { const size_t ci_ = (size_t)bh * 32 + (cc); \
        const bf16_t* RHg_ = (const bf16_t*)(A.ws + WS_RY + ci_ * 16384); const bf16_t* Y0g_ = RHg_ + 4096; const float* BCg_ = (const float*)(A.ws + WS_BC) + ci_ * 64; \
        _Pragma("unroll") for (int nn = 0; nn < 2; ++nn) { const int t = (nt0 + nn) * 16 + fr; const size_t row = (size_t)b * SEQ + (cc) * 64 + t; \
            _Pragma("unroll") for (int ks = 0; ks < 2; ++ks) bR[nn][ks] = *(const bf16x8*)(RHg_ + t * 64 + ks * 32 + q4 * 8); \
            y0_[nn] = *(const u32x2*)(Y0g_ + t * 64 + v0); zc_[nn] = *(const u32x2*)(Z + row * NZ + 1024 + colg); zp_[nn] = (u32x2){0u, 0u}; \
            if (!((cc) == 0 && t == 0)) zp_[nn] = *(const u32x2*)(Z + (row - 1) * NZ + 1024 + colg); \
            zg_[nn] = *(const u32x2*)(Z + row * NZ + O_GR + colg); bc_[nn] = BCg_[t]; } } while (0)
#define B_STEP(BP, QV, bR, y0_, zc_, zp_, zg_, bc_, cc) do { \
        const f32x4 lnw = *(const f32x4*)(A.ln_w + colg), lnb = *(const f32x4*)(A.ln_b + colg), muv = *(const f32x4*)(A.mu + 1024 + colg); \
        _Pragma("unroll") for (int nn = 0; nn < 2; ++nn) _Pragma("unroll") for (int jj = 0; jj < 4; ++jj) { const int v = mt * 16 + q4 * 4 + jj, i = (nt0 + nn) * 16 + fr; const float s_ = acc[nn][jj]; \
            const unsigned hi = pk2(s_, 0.f) & 0xffffu; const unsigned lo = pk2(s_ - bf2f(hi), 0.f) & 0xffffu; \
            *(LAS unsigned short*)(lds + CB_SH + v * 144 + i * 2) = (unsigned short)hi; *(LAS unsigned short*)(lds + CB_SL + v * 144 + i * 2) = (unsigned short)lo; } \
        LBAR(); \
        bf16x8 aH[2], aL[2]; \
        _Pragma("unroll") for (int ks = 0; ks < 2; ++ks) { aH[ks] = ldsfrag(lds + CB_SH, mt * 16 + fr, ks * 32 + q4 * 8); aL[ks] = ldsfrag(lds + CB_SL, mt * 16 + fr, ks * 32 + q4 * 8); } \
        float y_[2][4]; \
        _Pragma("unroll") for (int nn = 0; nn < 2; ++nn) { f32x4 an = QV[nn], ya = {0.f, 0.f, 0.f, 0.f}; \
            _Pragma("unroll") for (int ks = 0; ks < 2; ++ks) { an = MFMA16(aH[ks], BP[nn][ks], an); an = MFMA16(aL[ks], BP[nn][ks], an); ya = MFMA16(aH[ks], bR[nn][ks], ya); } \
            acc[nn] = an; const int t = (nt0 + nn) * 16 + fr; \
            y_[nn][0] = ya[0] + bflo(y0_[nn].x); y_[nn][1] = ya[1] + bfhi(y0_[nn].x); y_[nn][2] = ya[2] + bflo(y0_[nn].y); y_[nn][3] = ya[3] + bfhi(y0_[nn].y); \
            float s1 = (y_[nn][0] + y_[nn][1]) + (y_[nn][2] + y_[nn][3]), s2 = (y_[nn][0] * y_[nn][0] + y_[nn][1] * y_[nn][1]) + (y_[nn][2] * y_[nn][2] + y_[nn][3] * y_[nn][3]); \
            s1 += __shfl_xor(s1, 16); s1 += __shfl_xor(s1, 32); s2 += __shfl_xor(s2, 16); s2 += __shfl_xor(s2, 32); \
            if (q4 == 0) { ST[(mt * 64 + t) * 2] = s1; ST[(mt * 64 + t) * 2 + 1] = s2; } } \
        LBAR(); \
        _Pragma("unroll") for (int nn = 0; nn < 2; ++nn) { const int t = (nt0 + nn) * 16 + fr; float s1 = 0.f, s2 = 0.f; \
            _Pragma("unroll") for (int m = 0; m < 4; ++m) { s1 += ST[(m * 64 + t) * 2]; s2 += ST[(m * 64 + t) * 2 + 1]; } \
            const float mean = s1 * (1.f / 64.f); const float var = fmaxf(s2 * (1.f / 64.f) - mean * mean, 0.f); const float rstd = __builtin_amdgcn_rsqf(var + GN_EPS); \
            const size_t row = (size_t)b * SEQ + (cc) * 64 + t; \
            const float cv[4] = {bflo(zc_[nn].x), bfhi(zc_[nn].x), bflo(zc_[nn].y), bfhi(zc_[nn].y)}, pv[4] = {bflo(zp_[nn].x), bfhi(zp_[nn].x), bflo(zp_[nn].y), bfhi(zp_[nn].y)}, \
                        gv[4] = {bflo(zg_[nn].x), bfhi(zg_[nn].x), bflo(zg_[nn].y), bfhi(zg_[nn].y)}; \
            float o[4]; \
            _Pragma("unroll") for (int jj = 0; jj < 4; ++jj) { const float yn = (y_[nn][jj] - mean) * rstd * lnw[jj] + lnb[jj]; const float zsv = cv[jj] + muv[jj] * (pv[jj] - cv[jj]); \
                o[jj] = (yn + bc_[nn] * zsv) * siluf_(gv[jj]); } \
            *(u32x2*)(MIX + row * DM + colg) = pack4(o[0], o[1], o[2], o[3]); } } while (0)
    bf16x8 p0[2][2], p1[2][2]; f32x4 q0[2], q1[2];
    bf16x8 r0_[2][2], r1_[2][2]; u32x2 ya0[2], ya1[2], zc0[2], zc1[2], zp0[2], zp1[2], zg0[2], zg1[2]; float bc0[2], bc1[2];
    B_LOAD(p0, q0, 0); B_LOADY(r0_, ya0, zc0, zp0, zg0, bc0, 0);
#pragma unroll 1
    for (int c = 0; c < 32; ++c) {
        const int cn = c + 1 < 32 ? c + 1 : 31;
        B_LOAD(p1, q1, cn); B_LOADY(r1_, ya1, zc1, zp1, zg1, bc1, cn);
        B_STEP(p0, q0, r0_, ya0, zc0, zp0, zg0, bc0, c);
#pragma unroll
        for (int nn = 0; nn < 2; ++nn) { p0[nn][0] = p1[nn][0]; p0[nn][1] = p1[nn][1]; q0[nn] = q1[nn]; r0_[nn][0] = r1_[nn][0]; r0_[nn][1] = r1_[nn][1];
            ya0[nn] = ya1[nn]; zc0[nn] = zc1[nn]; zp0[nn] = zp1[nn]; zg0[nn] = zg1[nn]; bc0[nn] = bc1[nn]; }
    }
#undef B_LOAD
#undef B_LOADY
#undef B_STEP
    float* wo = A.out + OUT_WKVP + (size_t)bh * 4096;
#pragma unroll
    for (int nn = 0; nn < 2; ++nn)
#pragma unroll
        for (int jj = 0; jj < 4; ++jj) wo[(mt * 16 + q4 * 4 + jj) * 64 + (nt0 + nn) * 16 + fr] = acc[nn][jj];
    if ((bh & 7) == 0) { const size_t row = (size_t)b * SEQ + SEQ - 1; float* so = A.out + OUT_SHP + (size_t)b * SHIFT;
        for (int cix = tid; cix < SHIFT; cix += 512) so[cix] = bf2f(Z[row * NZ + cix]); }
    LBAR();
}

__device__ __forceinline__ void chunkC_item(const Args& A, LAS unsigned char* lds, int tid, int lane, int wave, int ci) {
    const int c = ci & 31, h = (ci >> 5) & 7, b = ci >> 8;
    const bf16_t* Z = (const bf16_t*)(A.ws + WS_Z); bf16_t* MIX = (bf16_t*)(A.ws + WS_XN);
    const int fr = lane & 15, q4 = lane >> 4, mt = wave >> 1, nt0 = (wave & 1) * 2, v0 = mt * 16 + q4 * 4;
    const bf16_t* Sg = (const bf16_t*)((const unsigned char*)A.out + CH_S + (size_t)ci * 8192);
    const bf16_t* RHg = (const bf16_t*)(A.ws + WS_RY + (size_t)ci * 16384); const bf16_t* Y0g = RHg + 4096;
    const float* BCg = (const float*)(A.ws + WS_BC) + (size_t)ci * 64;
    LAS float* ST = (LAS float*)lds;
    bf16x8 aS[2];
#pragma unroll
    for (int ks = 0; ks < 2; ++ks) aS[ks] = *(const bf16x8*)(Sg + (mt * 16 + fr) * 64 + ks * 32 + q4 * 8);
    const int colg = h * 64 + v0;
    u32x2 zcA[2], zpA[2], zgA[2]; float bcA[2];
#pragma unroll
    for (int nn = 0; nn < 2; ++nn) { const int t = (nt0 + nn) * 16 + fr; const size_t row = (size_t)b * SEQ + c * 64 + t;
        zcA[nn] = *(const u32x2*)(Z + row * NZ + 1024 + colg); zpA[nn] = (u32x2){0u, 0u}; if (!(c == 0 && t == 0)) zpA[nn] = *(const u32x2*)(Z + (row - 1) * NZ + 1024 + colg);
        zgA[nn] = *(const u32x2*)(Z + row * NZ + O_GR + colg); bcA[nn] = BCg[t]; }
    const f32x4 lnw = *(const f32x4*)(A.ln_w + colg), lnb = *(const f32x4*)(A.ln_b + colg), muv = *(const f32x4*)(A.mu + 1024 + colg);
    float y[2][4];
#pragma unroll
    for (int nn = 0; nn < 2; ++nn) { const int t = (nt0 + nn) * 16 + fr; f32x4 acc = {0.f, 0.f, 0.f, 0.f};
#pragma unroll
        for (int ks = 0; ks < 2; ++ks) acc = MFMA16(aS[ks], *(const bf16x8*)(RHg + t * 64 + ks * 32 + q4 * 8), acc);
        const u32x2 y0 = *(const u32x2*)(Y0g + t * 64 + v0);
        y[nn][0] = acc[0] + bflo(y0.x); y[nn][1] = acc[1] + bfhi(y0.x); y[nn][2] = acc[2] + bflo(y0.y); y[nn][3] = acc[3] + bfhi(y0.y);
        float s1 = (y[nn][0] + y[nn][1]) + (y[nn][2] + y[nn][3]), s2 = (y[nn][0] * y[nn][0] + y[nn][1] * y[nn][1]) + (y[nn][2] * y[nn][2] + y[nn][3] * y[nn][3]);
        s1 += __shfl_xor(s1, 16); s1 += __shfl_xor(s1, 32); s2 += __shfl_xor(s2, 16); s2 += __shfl_xor(s2, 32);
        if (q4 == 0) { ST[(mt * 64 + t) * 2] = s1; ST[(mt * 64 + t) * 2 + 1] = s2; } }
    LBAR();
#pragma unroll
    for (int nn = 0; nn < 2; ++nn) { const int t = (nt0 + nn) * 16 + fr; float s1 = 0.f, s2 = 0.f;
#pragma unroll
        for (int m = 0; m < 4; ++m) { s1 += ST[(m * 64 + t) * 2]; s2 += ST[(m * 64 + t) * 2 + 1]; }
        const float mean = s1 * (1.f / 64.f); const float var = fmaxf(s2 * (1.f / 64.f) - mean * mean, 0.f); const float rstd = __builtin_amdgcn_rsqf(var + GN_EPS);
        const size_t row = (size_t)b * SEQ + c * 64 + t;
        const u32x2 zc = zcA[nn], zp = zpA[nn], zg = zgA[nn];
        const float cv[4] = {bflo(zc.x), bfhi(zc.x), bflo(zc.y), bfhi(zc.y)}, pv[4] = {bflo(zp.x), bfhi(zp.x), bflo(zp.y), bfhi(zp.y)}, gv[4] = {bflo(zg.x), bfhi(zg.x), bflo(zg.y), bfhi(zg.y)};
        const float bc = bcA[nn]; float o[4];
#pragma unroll
        for (int jj = 0; jj < 4; ++jj) { const float yn = (y[nn][jj] - mean) * rstd * lnw[jj] + lnb[jj]; const float zsv = cv[jj] + muv[jj] * (pv[jj] - cv[jj]);
            o[jj] = (yn + bc * zsv) * siluf_(gv[jj]); }
        *(u32x2*)(MIX + row * DM + colg) = pack4(o[0], o[1], o[2], o[3]); }
    LBAR();
}

constexpr int AT_K = 0, AT_V = 36864, AT_P = 70656;
__device__ __forceinline__ void attn_prompt_item(const Args& A, LAS unsigned char* lds, int tid, int lane, int wave, int b, int nb, int kvh) {
    const bf16_t* Z = (const bf16_t*)(A.ws + WS_Z); bf16_t* MIX = (bf16_t*)(A.ws + WS_XN);
    const float* ct = (const float*)(A.ws + WS_ROPE); const float* st = ct + 2056 * 8;
    const int fr = lane & 15, q4 = lane >> 4;
    for (int idx = tid; idx < 2048; idx += 512) {
        const int key = idx & 255, ch = idx >> 8; const int pos = (nb - 1) * 128 + key;
        float kf[8], vf[8];
        if (pos >= 0) {
            const size_t row = (size_t)b * SEQ + pos; const bf16_t* kp = Z + row * NZ + O_K + kvh * 64;
            unpack8(*(const u32x4*)(kp + ch * 8), kf); unpack8(*(const u32x4*)(Z + row * NZ + O_V + kvh * 64 + ch * 8), vf);
            if (ch < 2) { float pf[8]; unpack8(*(const u32x4*)(kp + (ch ^ 1) * 8), pf);
#pragma unroll
                for (int i = 0; i < 8; ++i) { const float c = ct[pos * 8 + i], s = st[pos * 8 + i]; kf[i] = ch == 0 ? kf[i] * c - pf[i] * s : kf[i] * c + pf[i] * s; } }
            if (nb == NB - 1 && key >= 128) {
                float* ko = A.out + OUT_KP + ((size_t)(b * 128 + key - 128) * 2 + kvh) * 64 + ch * 8; float* vo = A.out + OUT_VP + ((size_t)(b * 128 + key - 128) * 2 + kvh) * 64 + ch * 8;
                *(f32x4*)ko = (f32x4){kf[0], kf[1], kf[2], kf[3]}; *(f32x4*)(ko + 4) = (f32x4){kf[4], kf[5], kf[6], kf[7]};
                *(f32x4*)vo = (f32x4){vf[0], vf[1], vf[2], vf[3]}; *(f32x4*)(vo + 4) = (f32x4){vf[4], vf[5], vf[6], vf[7]};
            }
        } else {
#pragma unroll
            for (int i = 0; i < 8; ++i) { kf[i] = 0.f; vf[i] = 0.f; }
        }
        *(LAS u32x4*)(lds + AT_K + key * 144 + ch * 16) = pack8(kf);
#pragma unroll
        for (int i = 0; i < 8; ++i) *(LAS unsigned short*)(lds + AT_V + (ch * 8 + i) * 528 + key * 2) = (unsigned short)f2bf(vf[i]);
    }
    __syncthreads();
    LAS unsigned char* Pw = lds + AT_P + wave * 2304;
    for (int task = wave; task < 16; task += 8) {
        const int g = task >> 2, tt = task & 3, hq = kvh * 4 + g;
        const float sink = A.sinks[hq] * 1.4426950408889634f;
        bf16x8 Qf[2][2];
#pragma unroll
        for (int mt = 0; mt < 2; ++mt)
#pragma unroll
            for (int ks = 0; ks < 2; ++ks) {
                const int tq = tt * 32 + mt * 16 + fr; const int pos = nb * 128 + tq; const size_t row = (size_t)b * SEQ + pos;
                const bf16_t* qp = Z + row * NZ + O_Q + hq * 64; const int d0 = ks * 32 + q4 * 8;
                float qf[8]; unpack8(*(const u32x4*)(qp + d0), qf);
                if (ks == 0 && q4 < 2) { float pf[8]; unpack8(*(const u32x4*)(qp + (d0 ^ 8)), pf);
#pragma unroll
                    for (int i = 0; i < 8; ++i) { const float c = ct[pos * 8 + i], s = st[pos * 8 + i]; qf[i] = q4 == 0 ? qf[i] * c - pf[i] * s : qf[i] * c + pf[i] * s; } }
#pragma unroll
                for (int i = 0; i < 8; ++i) qf[i] *= 0.18033688011112042f;
                Qf[mt][ks] = __builtin_bit_cast(bf16x8, pack8(qf));
            }
        float mrow[2][4], lrow[2][4]; f32x4 O[2][4];
#pragma unroll
        for (int mt = 0; mt < 2; ++mt) {
#pragma unroll
            for (int j = 0; j < 4; ++j) { mrow[mt][j] = sink; lrow[mt][j] = 1.f; }
#pragma unroll
            for (int dt = 0; dt < 4; ++dt) O[mt][dt] = (f32x4){0.f, 0.f, 0.f, 0.f};
        }
        unsigned short gts[2][4][4];
#pragma unroll
        for (int mt = 0; mt < 2; ++mt)
#pragma unroll
            for (int j = 0; j < 4; ++j) { const size_t row = (size_t)b * SEQ + nb * 128 + tt * 32 + mt * 16 + q4 * 4 + j;
#pragma unroll
                for (int dt = 0; dt < 4; ++dt) gts[mt][j][dt] = Z[row * NZ + O_GA + hq * 64 + dt * 16 + fr]; }
        int kc_lo = tt < 2 ? 0 : 1; const int kc_hi = kc_lo + 3; if (nb == 0 && kc_lo < 2) kc_lo = 2;
        for (int kc = kc_lo; kc < kc_hi; ++kc) {
#pragma unroll
            for (int mt = 0; mt < 2; ++mt) {
                f32x4 S[4];
#pragma unroll
                for (int nt = 0; nt < 4; ++nt) {
                    f32x4 acc = {0.f, 0.f, 0.f, 0.f};
#pragma unroll
                    for (int ks = 0; ks < 2; ++ks) { const bf16x8 Bk = *(const LAS bf16x8*)(lds + AT_K + (kc * 64 + nt * 16 + fr) * 144 + (ks * 32 + q4 * 8) * 2);
                        acc = __builtin_amdgcn_mfma_f32_16x16x32_bf16(Qf[mt][ks], Bk, acc, 0, 0, 0); }
                    S[nt] = acc;
                }
                float alpha[4];
#pragma unroll
                for (int j = 0; j < 4; ++j) {
                    const int dq = kc * 64 + fr - (tt * 32 + mt * 16 + q4 * 4 + j) - 1;
                    float mx = -1e30f;
#pragma unroll
                    for (int nt = 0; nt < 4; ++nt) { const bool ok = (unsigned)(dq + nt * 16) < 128u;
                        const float s = ok ? S[nt][j] : -1e30f; S[nt][j] = s; mx = fmaxf(mx, s); }
                    mx = red16_max(mx);
                    const float mn = fmaxf(mrow[mt][j], mx); alpha[j] = __builtin_amdgcn_exp2f(mrow[mt][j] - mn); mrow[mt][j] = mn;
                    float rs = 0.f;
#pragma unroll
                    for (int nt = 0; nt < 4; ++nt) { const float p = __builtin_amdgcn_exp2f(S[nt][j] - mn); S[nt][j] = p; rs += p; }
                    rs = red16_sum(rs); lrow[mt][j] = lrow[mt][j] * alpha[j] + rs;
                }
#pragma unroll
                for (int dt = 0; dt < 4; ++dt)
#pragma unroll
                    for (int j = 0; j < 4; ++j) O[mt][dt][j] *= alpha[j];
#pragma unroll
                for (int nt = 0; nt < 4; ++nt)
#pragma unroll
                    for (int j = 0; j < 4; ++j) *(LAS unsigned short*)(Pw + (q4 * 4 + j) * 144 + (nt * 16 + fr) * 2) = (unsigned short)f2bf(S[nt][j]);
                LDS_WAIT();
                bf16x8 Pa[2];
#pragma unroll
                for (int ks = 0; ks < 2; ++ks) Pa[ks] = *(const LAS bf16x8*)(Pw + fr * 144 + (ks * 32 + q4 * 8) * 2);
#pragma unroll
                for (int dt = 0; dt < 4; ++dt)
#pragma unroll
                    for (int ks = 0; ks < 2; ++ks) { const bf16x8 Bv = *(const LAS bf16x8*)(lds + AT_V + (dt * 16 + fr) * 528 + (kc * 64 + ks * 32 + q4 * 8) * 2);
                        O[mt][dt] = __builtin_amdgcn_mfma_f32_16x16x32_bf16(Pa[ks], Bv, O[mt][dt], 0, 0, 0); }
                LDS_WAIT();
            }
        }
#pragma unroll
        for (int mt = 0; mt < 2; ++mt)
#pragma unroll
            for (int j = 0; j < 4; ++j) {
                const int tq = tt * 32 + mt * 16 + q4 * 4 + j; const size_t row = (size_t)b * SEQ + nb * 128 + tq; const float il = __builtin_amdgcn_rcpf(lrow[mt][j]);
#pragma unroll
                for (int dt = 0; dt < 4; ++dt) { const int d = dt * 16 + fr; const float g = bf2f(gts[mt][j][dt]);
                    MIX[row * DM + 512 + hq * 64 + d] = (bf16_t)f2bf(O[mt][dt][j] * il * siluf_(g)); }
            }
    }
    __syncthreads();
}

constexpr int SA_K = 0, SA_V = 35456, SA_Q = 72448, SA_P = 80640;
__device__ __forceinline__ void attn_sample_item(const Args& A, LAS unsigned char* lds, int tid, int lane, int wave, int b, int kvh) {
    const bf16_t* Z = (const bf16_t*)(A.ws + WS_Z); bf16_t* MIX = (bf16_t*)(A.ws + WS_XN);
    const float* ct = (const float*)(A.ws + WS_ROPE); const float* st = ct + 2056 * 8;
    LAS float* SK = (LAS float*)(lds + SA_K); LAS float* SV = (LAS float*)(lds + SA_V); LAS float* SQ = (LAS float*)(lds + SA_Q); LAS float* SP = (LAS float*)(lds + SA_P);
    float* ko = A.out + OUT_KS + (size_t)b * 128 * 128; float* vo = A.out + OUT_VS + (size_t)b * 128 * 128;
    const int tn_ = tid >> 6, dn_ = tid & 63; const size_t rown_ = (size_t)MP + b * 8 + tn_; const bf16_t* kpn_ = Z + rown_ * NZ + O_K + kvh * 64;
    const unsigned short kraw_ = kpn_[dn_], kpar_ = kpn_[dn_ ^ 8], vraw_ = Z[rown_ * NZ + O_V + kvh * 64 + dn_];
    const float kc_ = ct[(2048 + tn_) * 8 + (dn_ & 7)], ks_ = st[(2048 + tn_) * 8 + (dn_ & 7)];
    unsigned short qraw_[4], qpar_[4]; float qc_[4], qs_[4];
#pragma unroll
    for (int i = 0; i < 4; ++i) { const int idx = tid + 512 * i, qi = idx >> 6, d = idx & 63, t = qi >> 2, g = qi & 3, hq = kvh * 4 + g; const bf16_t* qp = Z + ((size_t)MP + b * 8 + t) * NZ + O_Q + hq * 64;
        qraw_[i] = qp[d]; qpar_[i] = qp[d ^ 8]; qc_[i] = ct[(2048 + t) * 8 + (d & 7)]; qs_[i] = st[(2048 + t) * 8 + (d & 7)]; }
    u32x2 graw_; { const int qi = tid >> 4, d0 = (tid & 15) * 4, t = qi >> 2, g = qi & 3, hq = kvh * 4 + g; graw_ = *(const u32x2*)(Z + ((size_t)MP + b * 8 + t) * NZ + O_GA + hq * 64 + d0); }
    {
        f32x4 kq[4], vq[4];
#pragma unroll
        for (int i = 0; i < 4; ++i) { const int idx = tid + 512 * i, w = idx >> 4, d4 = (idx & 15) * 4; const size_t gi = ((size_t)(b * 128 + w) * 2 + kvh) * 64 + d4;
            kq[i] = *(const f32x4*)(A.cache_k + gi); vq[i] = *(const f32x4*)(A.cache_v + gi); }
#pragma unroll
        for (int i = 0; i < 4; ++i) { const int idx = tid + 512 * i, w = idx >> 4, d4 = (idx & 15) * 4;
            SK[w * 65 + d4] = kq[i].x; SK[w * 65 + d4 + 1] = kq[i].y; SK[w * 65 + d4 + 2] = kq[i].z; SK[w * 65 + d4 + 3] = kq[i].w;
            *(LAS f32x4*)(SV + w * 68 + d4) = vq[i];
            if (w >= 8) { *(f32x4*)(ko + ((w - 8) * 2 + kvh) * 64 + d4) = kq[i]; *(f32x4*)(vo + ((w - 8) * 2 + kvh) * 64 + d4) = vq[i]; } }
    }
    {
        const int t = tid >> 6, d = tid & 63; const size_t row = (size_t)MP + b * 8 + t; const bf16_t* kp = Z + row * NZ + O_K + kvh * 64;
        float kv = bf2f(kraw_);
        if (d < 16) { const float pr = bf2f(kpar_); kv = d < 8 ? kv * kc_ - pr * ks_ : kv * kc_ + pr * ks_; }
        const float vv = bf2f(vraw_);
        SK[(128 + t) * 65 + d] = kv; SV[(128 + t) * 68 + d] = vv;
        ko[((120 + t) * 2 + kvh) * 64 + d] = kv; vo[((120 + t) * 2 + kvh) * 64 + d] = vv;
    }
#pragma unroll
    for (int i = 0; i < 4; ++i) { const int idx = tid + 512 * i, qi = idx >> 6, d = idx & 63;
        float qv = bf2f(qraw_[i]);
        if (d < 16) { const float pr = bf2f(qpar_[i]); qv = d < 8 ? qv * qc_[i] - pr * qs_[i] : qv * qc_[i] + pr * qs_[i]; }
        SQ[qi * 64 + d] = qv * 0.125f;
    }
    __syncthreads();
    for (int idx = tid; idx < 32 * 136; idx += 512) {
        const int qi = idx / 136, ki = idx % 136, t = qi >> 2;
        const bool ok = ki < 128 ? (ki >= t + 1) : (ki - 128 <= t);
        float dot = 0.f;
#pragma unroll 4
        for (int d = 0; d < 64; d += 4) { const f32x4 q4v = *(const LAS f32x4*)(SQ + qi * 64 + d);
            dot += q4v.x * SK[ki * 65 + d] + q4v.y * SK[ki * 65 + d + 1] + q4v.z * SK[ki * 65 + d + 2] + q4v.w * SK[ki * 65 + d + 3]; }
        SP[qi * 136 + ki] = ok ? dot : -1e30f;
    }
    __syncthreads();
#pragma unroll
    for (int i = 0; i < 4; ++i) {
        const int qi = wave * 4 + i, g = qi & 3; const float sink = A.sinks[kvh * 4 + g];
        const float s0 = SP[qi * 136 + lane], s1 = SP[qi * 136 + 64 + lane], s2 = lane < 8 ? SP[qi * 136 + 128 + lane] : -1e30f;
        float mx = fmaxf(fmaxf(s0, s1), fmaxf(s2, sink));
#pragma unroll
        for (int o = 1; o < 64; o <<= 1) mx = fmaxf(mx, __shfl_xor(mx, o));
        const float p0 = __expf(s0 - mx), p1 = __expf(s1 - mx), p2 = __expf(s2 - mx);
        const float den = wave_sum(p0 + p1 + p2) + __expf(sink - mx); const float il = __builtin_amdgcn_rcpf(den);
        SP[qi * 136 + lane] = p0 * il; SP[qi * 136 + 64 + lane] = p1 * il; if (lane < 8) SP[qi * 136 + 128 + lane] = p2 * il;
    }
    __syncthreads();
    {
        const int qi = tid >> 4, d0 = (tid & 15) * 4, t = qi >> 2, g = qi & 3, hq = kvh * 4 + g;
        f32x4 acc = {0.f, 0.f, 0.f, 0.f};
        for (int k = 0; k < 136; ++k) { const float p = SP[qi * 136 + k]; const f32x4 v = *(const LAS f32x4*)(SV + k * 68 + d0); acc += p * v; }
        const size_t row = (size_t)MP + b * 8 + t;
        const float gt4[4] = {bflo(graw_.x), bfhi(graw_.x), bflo(graw_.y), bfhi(graw_.y)};
        *(u32x2*)(MIX + row * DM + 512 + hq * 64 + d0) = pack4(acc[0] * siluf_(gt4[0]), acc[1] * siluf_(gt4[1]), acc[2] * siluf_(gt4[2]), acc[3] * siluf_(gt4[3]));
    }
    __syncthreads();
}


__device__ __forceinline__ void grid_bar(unsigned* cnt, unsigned target) {
    asm volatile("s_waitcnt vmcnt(0)" ::: "memory");
    __syncthreads();
    if (threadIdx.x == 0) {
        __builtin_amdgcn_fence(__ATOMIC_RELEASE, "agent");
        asm volatile("s_waitcnt vmcnt(0)" ::: "memory");
        __hip_atomic_fetch_add(cnt, 1u, __ATOMIC_RELAXED, __HIP_MEMORY_SCOPE_AGENT);
        while (__hip_atomic_load(cnt, __ATOMIC_RELAXED, __HIP_MEMORY_SCOPE_AGENT) < target) __builtin_amdgcn_s_sleep(1);
        __builtin_amdgcn_fence(__ATOMIC_ACQUIRE, "agent");
        asm volatile("s_waitcnt vmcnt(0)" ::: "memory");
    }
    __syncthreads();
}


__device__ __forceinline__ void small_gemm(const bf16_t* Ab, int lda, const bf16_t* Bt, int ldb, int K, int row0, int col0, int lane, int wave, f32x4 (&acc)[2]) {
    const int fr = lane & 15, q4 = lane >> 4, mt = wave >> 1, nt0 = (wave & 1) * 2;
    const bf16_t* ap = Ab + (size_t)(row0 + mt * 16 + fr) * lda + q4 * 8;
    const bf16_t* bp0 = Bt + (size_t)(col0 + nt0 * 16 + fr) * ldb + q4 * 8; const bf16_t* bp1 = bp0 + (size_t)16 * ldb;
    acc[0] = (f32x4){0.f, 0.f, 0.f, 0.f}; acc[1] = (f32x4){0.f, 0.f, 0.f, 0.f};
    for (int k = 0; k < K; k += 256) {
        bf16x8 a[8], b0[8], b1[8];
#pragma unroll
        for (int i = 0; i < 8; ++i) { a[i] = *(const bf16x8*)(ap + k + 32 * i); b0[i] = *(const bf16x8*)(bp0 + k + 32 * i); b1[i] = *(const bf16x8*)(bp1 + k + 32 * i); }
        __builtin_amdgcn_sched_barrier(0);
#pragma unroll
        for (int i = 0; i < 8; ++i) { acc[0] = MFMA16(a[i], b0[i], acc[0]); acc[1] = MFMA16(a[i], b1[i], acc[1]); }
        __builtin_amdgcn_sched_barrier(0);
    }
}

__global__ void __launch_bounds__(512, 2) hymba_fwd(Args A) {
    extern __shared__ __attribute__((aligned(16))) unsigned char lds_raw[];
    LAS unsigned char* lds = (LAS unsigned char*)lds_raw;
    cg::grid_group grid = cg::this_grid();
    const int tid = threadIdx.x, lane = tid & 63, wave = __builtin_amdgcn_readfirstlane(tid >> 6);
    unsigned char* ws = A.ws;
    unsigned* ctl = (unsigned*)(ws + WS_CTL);
    float* rowss2 = (float*)(ctl + CW_SS2); float* rowss3 = (float*)(ctl + CW_SS3);
    bf16_t* Win_t = (bf16_t*)(ws + WS_WIN); bf16_t* Wout_t = (bf16_t*)(ws + WS_WOUT); bf16_t* Wpg_t = (bf16_t*)(ws + WS_WPG); bf16_t* Wpp_t = (bf16_t*)(ws + WS_WPP);
    bf16_t* XN = (bf16_t*)(ws + WS_XN); bf16_t* PB = (bf16_t*)(ws + WS_PB); bf16_t* PP = (bf16_t*)(ws + WS_PP); bf16_t* Zb = (bf16_t*)(ws + WS_Z);
    bf16_t* MIX = XN; bf16_t* H2B = Zb;

    unsigned bar_k = 0u;
#ifndef NO_P0
    p0_prologue(A, lds, tid, lane, wave);
#endif
    grid.sync();
#ifndef NO_P1
    {
        pg8::Gemm g{XN, Win_t, MTOT, NZ, DM}; pg8::StaticOrder S; S.init(MTOT, NZ, (int)gridDim.x, (int)blockIdx.x);
        pg8::EpiBf16 E{Zb, NZ};
        pg8::gemm_phase<pg8::EpiBf16, pg8::StaticOrder, true, true>(lds, g, S, E);
    }
    {
        const int G = (int)gridDim.x, tail = ((MTOT / 256) * (NZ / 256)) % G;
        pg8::Gemm g{PB, Wpp_t, MTOT, DM, PLE}; pg8::StaticOrder S;
        if (tail * 2 < G) S.init(MTOT, DM, G - tail, (int)blockIdx.x >= tail ? (int)blockIdx.x - tail : (1 << 28)); else S.init(MTOT, DM, G, (int)blockIdx.x);
        pg8::EpiBf16 E{PP, DM};
        pg8::gemm_phase<pg8::EpiBf16, pg8::StaticOrder, true, true>(lds, g, S, E);
    }
#endif
    grid_bar(ctl + CW_BAR, (unsigned)gridDim.x * (++bar_k));
#ifndef NO_P2
    {
        LAS int* s_item = (LAS int*)(lds + LDS_BYTES - 16);
        constexpr int N_CH = 4096, N_PB = 128, N_PA = 512, N_SA = 256, N_SS = 1024;
        { HeadConstA HC; HC.h = -1;
          for (int it = blockIdx.x; it < N_CH; it += gridDim.x) chunkA_item(A, lds, tid, lane, wave, it, it + (int)gridDim.x, HC); }
        grid_bar(ctl + CW_BAR, (unsigned)gridDim.x * (++bar_k));
        for (;;) {
            if (tid == 0) *s_item = (int)atomicAdd(ctl + CW_WORK + 1, 1u);
            __syncthreads();
            const int it = *s_item;
            __syncthreads();
            if (it >= N_PB) break;
            chunkB_item(A, lds, tid, lane, wave, it);
        }
        for (;;) {
            if (tid == 0) *s_item = (int)atomicAdd(ctl + CW_WORK + 3, 1u);
            __syncthreads();
            const int r = *s_item;
            __syncthreads();
            if (r >= N_PA) break;
            const int kvh = r & 1, nb = (r >> 1) & 15, b = r >> 5;
            attn_prompt_item(A, lds, tid, lane, wave, b, nb, kvh);
        }
        for (;;) {
            if (tid == 0) *s_item = (int)atomicAdd(ctl + CW_WORK + 2, 1u);
            __syncthreads();
            const int r = *s_item;
            __syncthreads();
            if (r >= 256) break;
            sscan_item(A, lds, tid, lane, wave, r >> 3, r & 7);
        }
        for (;;) {
            if (tid == 0) *s_item = (int)atomicAdd(ctl + CW_WORK + 4, 1u);
            __syncthreads();
            const int r = *s_item;
            __syncthreads();
            if (r >= N_SA) break;
            attn_sample_item(A, lds, tid, lane, wave, r >> 1, r & 1);
        }
    }
#endif
    grid_bar(ctl + CW_BAR, (unsigned)gridDim.x * (++bar_k));
#ifndef NO_P3
    {
        pg8::Gemm g{MIX, Wout_t, MP, DM, DM}; pg8::StaticOrder S; S.init(MP, DM, (int)gridDim.x, (int)blockIdx.x);
        pg8::EpiRes E{A.x_prompt, A.x_sample, A.out, H2B, rowss2};
        pg8::gemm_phase<pg8::EpiRes, pg8::StaticOrder, true, true>(lds, g, S, E);
    }
    {
        const int fr = lane & 15, q4 = lane >> 4;
        for (int tile = blockIdx.x; tile < 256; tile += gridDim.x) {
            const int row0 = MP + (tile >> 4) * 64, col0 = (tile & 15) * 64; f32x4 acc[2];
            small_gemm(MIX, DM, Wout_t, DM, DM, row0, col0, lane, wave, acc);
#pragma unroll
            for (int jj = 0; jj < 4; ++jj) { const int row = row0 + (wave >> 1) * 16 + q4 * 4 + jj; float ss = 0.f;
#pragma unroll
                for (int nn = 0; nn < 2; ++nn) { const int col = col0 + ((wave & 1) * 2 + nn) * 16 + fr; const float v = acc[nn][jj] + A.x_sample[(size_t)(row - MP) * DM + col];
                    H2B[(size_t)row * DM + col] = (bf16_t)f2bf(v); ss += v * v; }
                ss = red16_sum(ss); if (fr == 0) atomicAdd(rowss2 + row, ss); }
        }
    }
#endif
    grid_bar(ctl + CW_BAR, (unsigned)gridDim.x * (++bar_k));
#ifndef NO_P4
    {
        pg8::Gemm g{H2B, Wpg_t, MP, DM, DM}; pg8::StaticOrder S; S.init(MP, DM, (int)gridDim.x, (int)blockIdx.x);
        pg8::EpiGate E{H2B, XN, PP, rowss2, rowss3};
        pg8::gemm_phase<pg8::EpiGate, pg8::StaticOrder, true, true>(lds, g, S, E);
    }
    {
        const int fr = lane & 15, q4 = lane >> 4;
        for (int tile = blockIdx.x; tile < 256; tile += gridDim.x) {
            const int row0 = MP + (tile >> 4) * 64, col0 = (tile & 15) * 64; f32x4 acc[2];
            small_gemm(H2B, DM, Wpg_t, DM, DM, row0, col0, lane, wave, acc);
#pragma unroll
            for (int jj = 0; jj < 4; ++jj) { const int row = row0 + (wave >> 1) * 16 + q4 * 4 + jj; float ss = 0.f;
                const float rstd = __builtin_amdgcn_rsqf(rowss2[row] * (1.f / DM) + NORM_EPS);
#pragma unroll
                for (int nn = 0; nn < 2; ++nn) { const int col = col0 + ((wave & 1) * 2 + nn) * 16 + fr; const size_t o = (size_t)row * DM + col;
                    const float v = bf2f(H2B[o]) + sigmoidf_(acc[nn][jj] * rstd) * bf2f(PP[o]); XN[o] = (bf16_t)f2bf(v); ss += v * v; }
                ss = red16_sum(ss); if (fr == 0) atomicAdd(rowss3 + row, ss); }
        }
    }
#endif
    grid_bar(ctl + CW_BAR, (unsigned)gridDim.x * (++bar_k));
    {
        const int gw = blockIdx.x * 8 + wave, NGW = gridDim.x * 8;
        f32x4 gv[4];
#pragma unroll
        for (int j = 0; j < 4; ++j) gv[j] = *((const f32x4*)A.g_final + lane + 64 * j);
        u32x2 hw[4], nh[4]; float rs = 0.f, nrs = 0.f;
        int m = gw;
        if (m < MTOT) { const u32x2* hr = (const u32x2*)(XN + (size_t)m * DM) + lane;
#pragma unroll
            for (int j = 0; j < 4; ++j) hw[j] = hr[64 * j];
            rs = rowss3[m]; }
        for (; m < MTOT; m += NGW) {
            const int mn = m + NGW;
            if (mn < MTOT) { const u32x2* hr = (const u32x2*)(XN + (size_t)mn * DM) + lane;
#pragma unroll
                for (int j = 0; j < 4; ++j) nh[j] = hr[64 * j];
                nrs = rowss3[mn]; }
            const float rstd = __builtin_amdgcn_rsqf(rs * (1.f / DM) + NORM_EPS);
            f32x4* yr = (f32x4*)(A.out + (size_t)m * DM) + lane;
#pragma unroll
            for (int j = 0; j < 4; ++j) { f32x4 v = {bflo(hw[j].x), bfhi(hw[j].x), bflo(hw[j].y), bfhi(hw[j].y)}; v = v * rstd * gv[j]; yr[64 * j] = v; }
#pragma unroll
            for (int j = 0; j < 4; ++j) hw[j] = nh[j];
            rs = nrs;
        }
    }
}

extern "C" void kernel_launch(void* const* d_in, const int* in_sizes, int n_in, void* d_out, int out_size, void* d_ws, size_t ws_size, hipStream_t stream) {
    static int grid = 0;
    if (grid == 0) {
        if (n_in != 26 || ws_size < WS_END) { fprintf(stderr, "kernel_launch: unexpected n_in %d / ws %zu\n", n_in, ws_size); grid = -1; return; }
        int dev = 0, cus = 0, per_cu = 0;
        (void)hipGetDevice(&dev); (void)hipDeviceGetAttribute(&cus, hipDeviceAttributeMultiprocessorCount, dev);
        if (hipFuncSetAttribute((const void*)hymba_fwd, hipFuncAttributeMaxDynamicSharedMemorySize, LDS_BYTES) != hipSuccess) { fprintf(stderr, "kernel_launch: hipFuncSetAttribute failed\n"); grid = -1; return; }
        if (hipOccupancyMaxActiveBlocksPerMultiprocessor(&per_cu, (const void*)hymba_fwd, 512, LDS_BYTES) != hipSuccess || per_cu < 1) { fprintf(stderr, "kernel_launch: occupancy query says %d\n", per_cu); per_cu = 1; }
        (void)hipGetLastError();
        grid = cus * 1;
        if (grid <= 0) grid = 256;
    }
    if (grid < 0) return;
    Args a{};
    const float** pa = (const float**)&a;
    for (int i = 0; i < 26; ++i) pa[i] = (const float*)d_in[i];
    a.out = (float*)d_out; a.ws = (unsigned char*)d_ws;
    void* args[] = {&a};
    hipError_t e = hipLaunchCooperativeKernel((const void*)hymba_fwd, dim3(grid), dim3(512), args, LDS_BYTES, stream);
    if (e != hipSuccess) fprintf(stderr, "cooperative launch failed: %s (grid %d)\n", hipGetErrorString(e), grid);
}
```
